# Optimizing an MI355X kernel written in HIP

```python
import math
import jax, jax.numpy as jnp
from jax import lax
import numpy as np

D_MODEL = 2048
BATCH = 4
SEQ = 2048
DEPTH = 4

BRANCH_WIDTH = 3 * D_MODEL // 4
N_BRANCHES = 3
GMLP_CHUNK = 128
GMLP_GROUP_DIM = 128
GMLP_GROUPS = BRANCH_WIDTH // GMLP_GROUP_DIM
ATT_HEAD_DIM = 128
ATT_HEADS_PER_GROUP = 4
DILATED_GROUPS = ((128, 1), (512, 4), (2048, 16))
ATT_N_GROUPS = 3
ATT_HEADS = ATT_N_GROUPS * ATT_HEADS_PER_GROUP
ATT_QKV_WIDTH = ATT_HEADS * ATT_HEAD_DIM
ATT_OUT_WIDTH = ATT_HEADS_PER_GROUP * ATT_HEAD_DIM
ATT_BLOCK = 128
ROPE_THETA = 10000.0
SSM_D_INNER = BRANCH_WIDTH
SSM_HEAD_DIM = 64
SSM_HEADS = SSM_D_INNER // SSM_HEAD_DIM
SSM_GROUPS = 4
SSM_D_STATE = 128
SSM_CONV = 4
SSM_CHUNK = 128
SSM_CONV_DIM = SSM_D_INNER + 2 * SSM_GROUPS * SSM_D_STATE
IN_SIZES = (BRANCH_WIDTH, BRANCH_WIDTH, BRANCH_WIDTH,
            ATT_QKV_WIDTH, ATT_QKV_WIDTH, ATT_QKV_WIDTH, ATT_OUT_WIDTH,
            SSM_D_INNER, SSM_CONV_DIM, SSM_HEADS,
            D_MODEL, D_MODEL, D_MODEL)
N_IN = sum(IN_SIZES)

kernel_name = 'hybrid_gated_parallel_mixer'


def _rmsnorm(x, w, eps=1e-6):
    xf = x.astype(jnp.float32)
    y = xf * lax.rsqrt(jnp.mean(xf * xf, axis=-1, keepdims=True) + eps)
    return (y * w.astype(jnp.float32)).astype(x.dtype)


def _layernorm(x, w, b, eps=1e-5):
    xf = x.astype(jnp.float32)
    mu = jnp.mean(xf, axis=-1, keepdims=True)
    var = jnp.mean(jnp.square(xf - mu), axis=-1, keepdims=True)
    y = (xf - mu) * lax.rsqrt(var + eps)
    return (y * w.astype(jnp.float32) + b.astype(jnp.float32)).astype(x.dtype)


def _rope_tables(s):
    inv = 1.0 / (ROPE_THETA ** (jnp.arange(0, ATT_HEAD_DIM, 2, dtype=jnp.float32) / ATT_HEAD_DIM))
    ang = jnp.arange(s, dtype=jnp.float32)[:, None] * inv[None, :]
    return jnp.cos(ang), jnp.sin(ang)


def _rope(t, cos, sin):
    tf = t.astype(jnp.float32)
    t1, t2 = jnp.split(tf, 2, axis=-1)
    c = cos[None, :, None, :]
    s = sin[None, :, None, :]
    return jnp.concatenate([t1 * c - t2 * s, t2 * c + t1 * s], axis=-1).astype(t.dtype)


def _gmlp_chunked(u, v, zg, ln_w, ln_b, ws, bs):
    u = jax.nn.gelu(u)
    v = _layernorm(jax.nn.gelu(v), ln_w, ln_b)
    b, s, _ = v.shape
    vc = v.reshape(b, s // GMLP_CHUNK, GMLP_CHUNK, GMLP_GROUPS, GMLP_GROUP_DIM)
    causal = jnp.tril(jnp.ones((GMLP_CHUNK, GMLP_CHUNK), dtype=bool))
    wm = jnp.where(causal[None], ws, jnp.zeros_like(ws))
    mixed = jnp.einsum('gts,bcsge->bctge', wm, vc) + bs.T[None, None, :, :, None]
    mixed = mixed.reshape(b, s, BRANCH_WIDTH)
    return u * mixed * jax.nn.silu(zg)


def _banded_causal_attention(q, k, v, steps):
    n, lp, h, e = q.shape
    nb = lp // ATT_BLOCK
    qb = q.reshape(n, nb, ATT_BLOCK, h, e)
    kb = k.reshape(n, nb, ATT_BLOCK, h, e)
    vb = v.reshape(n, nb, ATT_BLOCK, h, e)

    def with_prev(t):
        prev = jnp.pad(t, ((0, 0), (1, 0), (0, 0), (0, 0), (0, 0)))[:, :-1]
        return jnp.concatenate([prev, t], axis=2)

    kc, vc = with_prev(kb), with_prev(vb)
    scale = 1.0 / math.sqrt(e)
    sc = jnp.einsum('nbqhe,nbkhe->nbhqk', qb, kc, preferred_element_type=jnp.float32) * scale
    qi = jnp.arange(ATT_BLOCK)[:, None] + ATT_BLOCK
    ki = jnp.arange(2 * ATT_BLOCK)[None, :]
    dist = qi - ki
    band = (dist >= 0) & (dist <= steps)
    blk = jnp.arange(nb)[:, None, None]
    exists = (blk * ATT_BLOCK + ki[None] - ATT_BLOCK) >= 0
    mask = band[None] & exists
    sc = jnp.where(mask[None, :, None], sc, -jnp.inf)
    lse = jax.nn.logsumexp(sc, axis=-1)
    p = jnp.exp(sc - lse[..., None])
    o = jnp.einsum('nbhqk,nbkhe->nbqhe', p.astype(v.dtype), vc).reshape(n, lp, h, e)
    lse = lse.transpose(0, 1, 3, 2).reshape(n, lp, h)
    return o, lse


def _dilated_group(q, k, v, window, dilation):
    b, s, h, e = q.shape
    l = s // dilation
    lp = -(-l // ATT_BLOCK) * ATT_BLOCK

    def to_res(t):
        t = t.reshape(b, l, dilation, h, e).transpose(0, 2, 1, 3, 4).reshape(b * dilation, l, h, e)
        return jnp.pad(t, ((0, 0), (0, lp - l), (0, 0), (0, 0)))

    o, lse = _banded_causal_attention(to_res(q), to_res(k), to_res(v), window // dilation)
    o = o[:, :l].reshape(b, dilation, l, h, e).transpose(0, 2, 1, 3, 4).reshape(b, s, h, e)
    lse = lse[:, :l].reshape(b, dilation, l, h).transpose(0, 2, 1, 3).reshape(b, s, h)
    return o, lse


def _dilated_attention(q, k, v, zg, cos, sin):
    b, s, _ = q.shape
    q = _rope(q.reshape(b, s, ATT_HEADS, ATT_HEAD_DIM), cos, sin)
    k = _rope(k.reshape(b, s, ATT_HEADS, ATT_HEAD_DIM), cos, sin)
    v = v.reshape(b, s, ATT_HEADS, ATT_HEAD_DIM)
    outs, lses = [], []
    for gi, (window, dil) in enumerate(DILATED_GROUPS):
        sl = slice(gi * ATT_HEADS_PER_GROUP, (gi + 1) * ATT_HEADS_PER_GROUP)
        o, lse = _dilated_group(q[:, :, sl], k[:, :, sl], v[:, :, sl], window, dil)
        outs.append(o)
        lses.append(lse)
    wts = jax.nn.softmax(jnp.stack(lses, axis=0), axis=0)
    o = jnp.sum(wts[..., None] * jnp.stack(outs, axis=0).astype(jnp.float32), axis=0)
    o = o.astype(zg.dtype).reshape(b, s, ATT_OUT_WIDTH)
    return o * jax.nn.silu(zg)


def _ssd_chunked(x, dt, a, bm, cm):
    b, s, h, p = x.shape
    g, n = bm.shape[2], bm.shape[3]
    j = h // g
    c = s // SSM_CHUNK
    l = SSM_CHUNK
    xdt = (x * dt[..., None]).reshape(b, c, l, g, j, p)
    bm = bm.reshape(b, c, l, g, n)
    cm = cm.reshape(b, c, l, g, n)
    da = (dt * a).reshape(b, c, l, g, j).transpose(0, 3, 4, 1, 2)
    cum = jnp.cumsum(da, axis=-1)
    seg = cum[..., :, None] - cum[..., None, :]
    causal = jnp.tril(jnp.ones((l, l), dtype=bool))
    decay = jnp.exp(jnp.where(causal, seg, -jnp.inf))
    cb = jnp.einsum('bctgn,bcsgn->bgcts', cm, bm)
    y_diag = jnp.einsum('bgcts,bgjcts,bcsgjp->bctgjp', cb, decay, xdt)
    decay_states = jnp.exp(cum[..., -1:] - cum)
    states = jnp.einsum('bclgn,bgjcl,bclgjp->bcgjpn', bm, decay_states, xdt)
    chunk_decay = jnp.exp(cum[..., -1])

    def step(h_prev, inp):
        st, dec = inp
        return h_prev * dec[..., None, None] + st, h_prev

    init = jnp.zeros((b, g, j, p, n), dtype=jnp.float32)
    _, prev = lax.scan(step, init, (jnp.moveaxis(states, 1, 0), jnp.moveaxis(chunk_decay, -1, 0)))
    prev = jnp.moveaxis(prev, 0, 1)
    y_off = jnp.einsum('bctgn,bcgjpn,bgjct->bctgjp', cm, prev, jnp.exp(cum))
    return (y_diag + y_off).reshape(b, s, h, p)


def _mamba2(zc, xbc, dt_raw, conv_w, conv_b, dt_bias, a_log, d_skip, norm_w):
    b, s, _ = xbc.shape
    xbc = lax.conv_general_dilated(xbc, conv_w[:, None, :], window_strides=(1,),
                                   padding=[(SSM_CONV - 1, 0)],
                                   dimension_numbers=('NWC', 'WIO', 'NWC'),
                                   feature_group_count=SSM_CONV_DIM) + conv_b
    xbc = jax.nn.silu(xbc).astype(jnp.float32)
    xs, bm, cm = jnp.split(xbc, [SSM_D_INNER, SSM_D_INNER + SSM_GROUPS * SSM_D_STATE], axis=-1)
    dt = jax.nn.softplus(dt_raw.astype(jnp.float32) + dt_bias.astype(jnp.float32))
    a = -jnp.exp(a_log.astype(jnp.float32))
    xh = xs.reshape(b, s, SSM_HEADS, SSM_HEAD_DIM)
    y = _ssd_chunked(xh, dt, a, bm.reshape(b, s, SSM_GROUPS, SSM_D_STATE),
                     cm.reshape(b, s, SSM_GROUPS, SSM_D_STATE))
    y = y + d_skip.astype(jnp.float32)[:, None] * xh
    y = y.reshape(b, s, SSM_D_INNER) * jax.nn.silu(zc.astype(jnp.float32))
    yg = y.reshape(b, s, SSM_GROUPS, SSM_D_INNER // SSM_GROUPS)
    yg = yg * lax.rsqrt(jnp.mean(yg * yg, axis=-1, keepdims=True) + 1e-5)
    y = yg.reshape(b, s, SSM_D_INNER) * norm_w.astype(jnp.float32)
    return y.astype(zc.dtype)


def _layer(x, norm_w, w_in, ln_w, ln_b, ws, bs, conv_w, conv_b, dt_bias, a_log, d_skip,
           ssm_norm_w, wa, wb, wc, w_out, cos, sin):
    h = _rmsnorm(x, norm_w)
    proj = h @ w_in
    offs = [int(o) for o in np.cumsum(IN_SIZES)[:-1]]
    (ua, va, za, qb, kb, vb, zb, zc, xbc, dtc, gra, grb, grc) = jnp.split(proj, offs, axis=-1)
    ya = _gmlp_chunked(ua, va, za, ln_w, ln_b, ws, bs)
    yb = _dilated_attention(qb, kb, vb, zb, cos, sin)
    yc = _mamba2(zc, xbc, dtc, conv_w, conv_b, dt_bias, a_log, d_skip, ssm_norm_w)
    merged = (jax.nn.sigmoid(gra) * (ya @ wa)
              + jax.nn.sigmoid(grb) * (yb @ wb)
              + jax.nn.sigmoid(grc) * (yc @ wc))
    return x + merged @ w_out


def setup_inputs(seed: int = 0) -> dict:
    key = jax.random.key(seed)
    ks = jax.random.split(key, 20)
    f32 = jnp.float32
    nrm = lambda k, shape, sc: jax.random.normal(k, shape, f32) * sc
    dt_u = jax.random.uniform(ks[9], (DEPTH, SSM_HEADS), f32)
    dt0 = jnp.exp(dt_u * (math.log(0.1) - math.log(0.001)) + math.log(0.001))
    return {
        'x': nrm(ks[0], (BATCH, SEQ, D_MODEL), 1.0),
        'norm_w': 1.0 + nrm(ks[1], (DEPTH, D_MODEL), 0.02),
        'w_in': nrm(ks[2], (DEPTH, D_MODEL, N_IN), D_MODEL ** -0.5),
        'gmlp_ln_w': 1.0 + nrm(ks[3], (DEPTH, BRANCH_WIDTH), 0.02),
        'gmlp_ln_b': nrm(ks[4], (DEPTH, BRANCH_WIDTH), 0.02),
        'gmlp_ws': nrm(ks[5], (DEPTH, GMLP_GROUPS, GMLP_CHUNK, GMLP_CHUNK), 0.5 * GMLP_CHUNK ** -0.5),
        'gmlp_bs': 1.0 + nrm(ks[6], (DEPTH, GMLP_GROUPS, GMLP_CHUNK), 0.02),
        'conv_w': nrm(ks[7], (DEPTH, SSM_CONV, SSM_CONV_DIM), SSM_CONV ** -0.5),
        'conv_b': nrm(ks[8], (DEPTH, SSM_CONV_DIM), 0.02),
        'dt_bias': dt0 + jnp.log(-jnp.expm1(-dt0)),
        'a_log': jnp.log(jax.random.uniform(ks[10], (DEPTH, SSM_HEADS), f32, 1.0, 16.0)),
        'd_skip': 1.0 + nrm(ks[11], (DEPTH, SSM_HEADS), 0.02),
        'ssm_norm_w': 1.0 + nrm(ks[12], (DEPTH, SSM_D_INNER), 0.02),
        'w_branch_a': nrm(ks[13], (DEPTH, BRANCH_WIDTH, D_MODEL), BRANCH_WIDTH ** -0.5),
        'w_branch_b': nrm(ks[14], (DEPTH, ATT_OUT_WIDTH, D_MODEL), ATT_OUT_WIDTH ** -0.5),
        'w_branch_c': nrm(ks[15], (DEPTH, SSM_D_INNER, D_MODEL), SSM_D_INNER ** -0.5),
        'w_out': nrm(ks[16], (DEPTH, D_MODEL, D_MODEL), 0.5 * D_MODEL ** -0.5),
        'final_norm_w': 1.0 + nrm(ks[17], (D_MODEL,), 0.02),
    }


def reference(x, norm_w, w_in, gmlp_ln_w, gmlp_ln_b, gmlp_ws, gmlp_bs, conv_w, conv_b, dt_bias,
              a_log, d_skip, ssm_norm_w, w_branch_a, w_branch_b, w_branch_c, w_out, final_norm_w):
    cos, sin = _rope_tables(x.shape[1])
    for i in range(DEPTH):
        x = _layer(x, norm_w[i], w_in[i], gmlp_ln_w[i], gmlp_ln_b[i], gmlp_ws[i], gmlp_bs[i],
                   conv_w[i], conv_b[i], dt_bias[i], a_log[i], d_skip[i], ssm_norm_w[i],
                   w_branch_a[i], w_branch_b[i], w_branch_c[i], w_out[i], cos, sin)
    return _rmsnorm(x, final_norm_w)
```

```cpp
#include <hip/hip_runtime.h>
#include <hip/hip_cooperative_groups.h>
#include <cstdio>
namespace cg = cooperative_groups;

#define LAS __attribute__((address_space(3)))
typedef unsigned short bf16_t;
typedef short bf16x8 __attribute__((ext_vector_type(8)));
typedef float f32x4 __attribute__((ext_vector_type(4)));
typedef unsigned u32x4 __attribute__((ext_vector_type(4)));
typedef unsigned u32x2 __attribute__((ext_vector_type(2)));

#ifndef N_LAUNCH_MODE
#define N_LAUNCH_MODE 1
#endif

constexpr int SEQ = 2048, MTOK = 8192, DM = 2048, NLAYER = 4;
constexpr int NIN = 19992, NP = 20224;
constexpr int C_U = 0, C_V = 1536, C_ZA = 3072, C_Q = 4608, C_K = 6144, C_VV = 7680, C_ZB = 9216, C_ZC = 9728, C_XBC = 11264, C_DT = 13824, C_GR = 14080;
constexpr int KBR = 3584;
constexpr int NPHASE = 2 + 5 * NLAYER;
constexpr int LDS_BYTES = 147456;

constexpr size_t al256(size_t x) { return (x + 255) & ~(size_t)255; }
constexpr size_t WS_ROWSS = 0;
constexpr size_t WS_LNST  = al256(WS_ROWSS + 5 * (size_t)MTOK * 8);
constexpr size_t WS_COS   = al256(WS_LNST + 4 * (size_t)MTOK * 2 * 8);
constexpr size_t WS_SIN   = al256(WS_COS + (size_t)SEQ * 64 * 4);
constexpr size_t WS_DTB   = al256(WS_SIN + (size_t)SEQ * 64 * 4);
constexpr size_t WS_CUM   = al256(WS_DTB + (size_t)MTOK * 24 * 4);
constexpr size_t WS_CDEC  = al256(WS_CUM + (size_t)MTOK * 24 * 4);
constexpr size_t WS_LSE   = al256(WS_CDEC + 4 * 16 * 24 * 4);
constexpr size_t WS_WIN   = al256(WS_LSE + 3 * (size_t)MTOK * 4 * 4);
constexpr size_t WS_WBR   = al256(WS_WIN + (size_t)NLAYER * NP * DM * 2);
constexpr size_t WS_WOUT  = al256(WS_WBR + (size_t)NLAYER * DM * KBR * 2);
constexpr size_t WS_XB    = al256(WS_WOUT + (size_t)NLAYER * DM * DM * 2);
constexpr size_t WS_X32   = al256(WS_XB + (size_t)MTOK * DM * 2);
constexpr size_t WS_P     = al256(WS_X32 + (size_t)MTOK * DM * 4);
constexpr size_t WS_XCV   = al256(WS_P + (size_t)MTOK * NP * 2);
constexpr size_t WS_ST    = al256(WS_XCV + (size_t)MTOK * 2560 * 2);
constexpr size_t WS_OG    = al256(WS_ST + (size_t)4 * 16 * 24 * 64 * 128 * 2);
constexpr size_t WS_Y     = al256(WS_OG + 3 * (size_t)MTOK * 512 * 2);
constexpr size_t WS_MG32  = al256(WS_Y + (size_t)MTOK * KBR * 2);
constexpr size_t WS_MGB   = al256(WS_MG32 + (size_t)MTOK * DM * 4);
constexpr size_t WS_TBL   = al256(WS_MGB + (size_t)MTOK * DM * 2);
constexpr size_t WS_BAR   = WS_TBL + 256;
constexpr size_t WS_PREV  = WS_BAR + 16384;
constexpr size_t WS_END   = al256(WS_PREV + (size_t)4 * 16 * 24 * 64 * 128 * 2);

__device__ __forceinline__ float bf_lo(unsigned u) { return __uint_as_float(u << 16); }
__device__ __forceinline__ float bf_hi(unsigned u) { return __uint_as_float(u & 0xffff0000u); }
typedef __bf16 bf16v2_t __attribute__((ext_vector_type(2)));
typedef float f32v2_t __attribute__((ext_vector_type(2)));
__device__ __forceinline__ unsigned pk_bf16(float lo, float hi) { f32v2_t v = {lo, hi}; bf16v2_t r = __builtin_convertvector(v, bf16v2_t); return __builtin_bit_cast(unsigned, r); }
__device__ __forceinline__ float fexp(float x) { return __builtin_amdgcn_exp2f(x * 1.44269504089f); }
__device__ __forceinline__ float frcp(float x) { return __builtin_amdgcn_rcpf(x); }
__device__ __forceinline__ float sigm(float x) { return frcp(1.f + fexp(-x)); }
__device__ __forceinline__ float silu_(float x) { return x * sigm(x); }
__device__ __forceinline__ float gelu_(float x) { return x * sigm(1.5957691216f * (x + 0.044715f * x * x * x)); }
__device__ __forceinline__ void unpack8(const u32x4 v, float (&f)[8]) { f[0] = bf_lo(v.x); f[1] = bf_hi(v.x); f[2] = bf_lo(v.y); f[3] = bf_hi(v.y); f[4] = bf_lo(v.z); f[5] = bf_hi(v.z); f[6] = bf_lo(v.w); f[7] = bf_hi(v.w); }
__device__ __forceinline__ u32x4 pack8(const float (&f)[8]) { u32x4 o; o.x = pk_bf16(f[0], f[1]); o.y = pk_bf16(f[2], f[3]); o.z = pk_bf16(f[4], f[5]); o.w = pk_bf16(f[6], f[7]); return o; }
__device__ __forceinline__ bf16x8 frag2(u32x2 a, u32x2 b) { u32x4 t; t.x = a.x; t.y = a.y; t.z = b.x; t.w = b.y; return __builtin_bit_cast(bf16x8, t); }
__device__ __forceinline__ bf16x8 ldsfrag(const LAS unsigned char* p) { return *(const LAS bf16x8*)p; }
typedef unsigned long long u64;
constexpr float RSS_SCALE = 65536.f, LNS_SCALE = 1048576.f;
__device__ __forceinline__ void fx_add(u64* p, float v, float scale) { __hip_atomic_fetch_add(p, (u64)(long long)__float2ll_rn(v * scale), __ATOMIC_RELAXED, __HIP_MEMORY_SCOPE_AGENT); }
__device__ __forceinline__ float fx_get(const u64* p, float inv_scale) { return (float)(long long)(*p) * inv_scale; }
__device__ __forceinline__ int swz(int row, int col) { return (((col >> 3) ^ ((row >> 3) & 15)) << 3) | (col & 7); }
#define MFMA16(a, b, c) __builtin_amdgcn_mfma_f32_16x16x32_bf16((a), (b), (c), 0, 0, 0)
#define LDS_WAIT() asm volatile("s_waitcnt lgkmcnt(0)" ::: "memory")

namespace pg8 {
constexpr int BM = 256, BK = 64, HALF = 128, HTB = HALF * BK * 2, NXCD = 8, WGM = 4;
__device__ __forceinline__ int lds_byte(int r, int c) { const int st = (r >> 4) * 2 + (c >> 5), rr = r & 15, cc = c & 31, ob = rr * 64 + cc * 2; return st * 1024 + (ob ^ (((ob >> 9) & 1) << 5)); }
__device__ __forceinline__ void stage_rc(int b, int& R, int& C) { const int st = b / 1024, sb = b % 1024, swz = sb ^ (((sb >> 9) & 1) << 5); R = (st >> 1) * 16 + swz / 64; C = (st & 1) * 32 + (swz % 64) / 2; }
__device__ __forceinline__ int perm32(int rho) { const int n = rho >> 4, i = rho & 15; return 8 * (i >> 2) + 4 * n + (i & 3); }

struct Unit { int pm, pn, k0, nt, br; };
struct Gemm { const bf16_t* A; const bf16_t* Bt; int lda, ldb; };
struct Sched {
    int nM, nN, nwg, G, c, mode, nt0;
    __device__ void init(int nM_, int nN_, int G_, int c_, int mode_, int nt_) { nM = nM_; nN = nN_; nwg = nM * nN; G = G_; c = c_; mode = mode_; nt0 = nt_; }
    __device__ bool tile(int round, int& pm, int& pn) const {
        const long L = (long)round * G + c; if (L >= nwg) return false;
        int wgid = (int)L; { const int q = nwg / NXCD, r = nwg % NXCD, xcd = wgid % NXCD, off = wgid / NXCD; wgid = (xcd < r ? xcd * (q + 1) : r * (q + 1) + (xcd - r) * q) + off; }
        const int nig = WGM * nN, gid = wgid / nig, fm = gid * WGM, gsz = (nM - fm) < WGM ? (nM - fm) : WGM;
        pm = fm + ((wgid % nig) % gsz); pn = (wgid % nig) / gsz; return true;
    }
    __device__ bool next(int i, Unit& u) const {
        if (mode == 0) { u.k0 = 0; u.nt = nt0; u.br = 0; return tile(i, u.pm, u.pn); }
        const int rd = i / 3, br = i - 3 * rd; u.br = br; u.k0 = br == 0 ? 0 : (br == 1 ? 1536 : 2048); u.nt = br == 1 ? 8 : 24; return tile(rd, u.pm, u.pn);
    }
};

template <class Epi>
__device__ __forceinline__ void gemm_phase(LAS unsigned char* lds, const Gemm g, const Sched& S, const Epi& E) {
    int tid = threadIdx.x; asm volatile("" : "+v"(tid));
    const int wid = __builtin_amdgcn_readfirstlane(tid >> 6), lane = tid & 63, wr = wid >> 2, wc = wid & 3, fr = lane & 15, fq = lane >> 4;
    unsigned voffA[2], voffB[2];
#pragma unroll
    for (int i = 0; i < 2; ++i) { int R, C; stage_rc(tid * 16 + i * 8192, R, C); const int Rb = (R & ~31) + perm32(R & 31);
        voffA[i] = (unsigned)(R * g.lda + C) * 2u; voffB[i] = (unsigned)(Rb * g.ldb + C) * 2u; }
    const size_t kstep = (size_t)(BK * 2);
    const size_t hstepA = (size_t)HALF * g.lda * 2, hstepB = (size_t)HALF * g.ldb * 2;
    const unsigned ldsw = (unsigned)wid * 1024u;
    const int aoff = lds_byte(wr * 64 + fr, fq * 8), boff = lds_byte(wc * 32 + fr, fq * 8);
#define PG8_SA(b, h) (((b) * 2 + (h)) * HTB)
#define PG8_SB(b, h) ((4 + (b) * 2 + (h)) * HTB)
#define PG8_STAGE(bufoff, gbase, voff) do { _Pragma("unroll") for (int _i = 0; _i < 2; ++_i) \
        __builtin_amdgcn_global_load_lds((const unsigned*)((const char*)(gbase) + (voff)[_i]), (LAS unsigned*)(lds + (bufoff) + ldsw + _i * 8192), 16, 0, 0); } while (0)
#define PG8_LDA(dst, b, h) do { _Pragma("unroll") for (int m = 0; m < 4; ++m) _Pragma("unroll") for (int k = 0; k < 2; ++k) dst[m][k] = *(const LAS bf16x8*)(lds + PG8_SA(b, h) + aoff + m * 2048 + k * 1024); } while (0)
#define PG8_LDB(dst, b, h) do { _Pragma("unroll") for (int n = 0; n < 2; ++n) _Pragma("unroll") for (int k = 0; k < 2; ++k) dst[n][k] = *(const LAS bf16x8*)(lds + PG8_SB(b, h) + boff + n * 2048 + k * 1024); } while (0)
#define PG8_MMA(ai, bj, At, Bt) do { __builtin_amdgcn_s_setprio(1); _Pragma("unroll") for (int m = 0; m < 4; ++m) _Pragma("unroll") for (int n = 0; n < 2; ++n) _Pragma("unroll") for (int k = 0; k < 2; ++k) \
        acc[ai][bj][m][n] = __builtin_amdgcn_mfma_f32_16x16x32_bf16(Bt[n][k], At[m][k], acc[ai][bj][m][n], 0, 0, 0); __builtin_amdgcn_s_setprio(0); } while (0)
#define PG8_WAIT_V(n) asm volatile("s_waitcnt vmcnt(" #n ")" ::: "memory")
#define PG8_WAIT_L(n) asm volatile("s_waitcnt lgkmcnt(" #n ")" ::: "memory")
#define PG8_BAR __builtin_amdgcn_s_barrier()
#define PG8_SCHED __builtin_amdgcn_sched_barrier(0)
    Unit cur, nxt; int ui = 0;
    if (!S.next(0, cur)) return;
    f32x4 acc[2][2][4][2];
#pragma unroll
    for (int a = 0; a < 2; ++a)
#pragma unroll
        for (int b = 0; b < 2; ++b)
#pragma unroll
            for (int m = 0; m < 4; ++m)
#pragma unroll
                for (int n = 0; n < 2; ++n) acc[a][b][m][n] = (f32x4){0.f, 0.f, 0.f, 0.f};
    bf16x8 At[4][2], B0[2][2], B1[2][2];
    const char* cA = (const char*)g.A + (size_t)cur.pm * 2 * hstepA + (size_t)cur.k0 * 2;
    const char* cB = (const char*)g.Bt + (size_t)cur.pn * 2 * hstepB + (size_t)cur.k0 * 2;
    asm volatile("" : "+s"(cA), "+s"(cB), "+v"(voffA[0]), "+v"(voffA[1]), "+v"(voffB[0]), "+v"(voffB[1]));
    PG8_STAGE(PG8_SB(0, 0), cB, voffB); PG8_STAGE(PG8_SB(0, 1), cB + hstepB, voffB); PG8_STAGE(PG8_SA(0, 0), cA, voffA); PG8_STAGE(PG8_SA(0, 1), cA + hstepA, voffA);
    if (wr == 1) PG8_BAR;
    PG8_WAIT_V(2); PG8_BAR;
    PG8_STAGE(PG8_SB(1, 0), cB + kstep, voffB); PG8_STAGE(PG8_SA(1, 0), cA + kstep, voffA); PG8_STAGE(PG8_SB(1, 1), cB + hstepB + kstep, voffB);
    PG8_WAIT_V(6); PG8_BAR;
    for (;;) {
        const bool has_next = S.next(ui + 1, nxt);
        const char* nA = has_next ? (const char*)g.A + (size_t)nxt.pm * 2 * hstepA + (size_t)nxt.k0 * 2 : cA;
        const char* nB = has_next ? (const char*)g.Bt + (size_t)nxt.pn * 2 * hstepB + (size_t)nxt.k0 * 2 : cB;
        const int nt = cur.nt;
        for (int t = 0; t < nt; t += 2) {
            const bool last = (t == nt - 2);
            const char* a1 = cA + (size_t)(t + 1) * kstep;
            const char* a2 = last ? nA : cA + (size_t)(t + 2) * kstep; const char* b2 = last ? nB : cB + (size_t)(t + 2) * kstep;
            const char* a3 = a2 + kstep; const char* b3 = b2 + kstep;
            PG8_LDB(B0, 0, 0); PG8_LDB(B1, 0, 1); PG8_SCHED; PG8_LDA(At, 0, 0); PG8_STAGE(PG8_SA(1, 1), a1 + hstepA, voffA);
            PG8_WAIT_V(8); PG8_WAIT_L(0); PG8_BAR; PG8_MMA(0, 0, At, B0); PG8_MMA(0, 1, At, B1); PG8_BAR; PG8_SCHED;
            PG8_LDA(At, 0, 1); PG8_STAGE(PG8_SB(0, 0), b2, voffB); PG8_STAGE(PG8_SB(0, 1), b2 + hstepB, voffB); PG8_STAGE(PG8_SA(0, 0), a2, voffA);
            PG8_WAIT_V(8); PG8_WAIT_L(0); PG8_BAR; PG8_MMA(1, 0, At, B0); PG8_MMA(1, 1, At, B1); PG8_BAR; PG8_SCHED;
            PG8_LDB(B0, 1, 0); PG8_LDB(B1, 1, 1); PG8_SCHED; PG8_LDA(At, 1, 0); PG8_STAGE(PG8_SA(0, 1), a2 + hstepA, voffA);
            PG8_WAIT_V(8); PG8_WAIT_L(0); PG8_BAR; PG8_MMA(0, 0, At, B0); PG8_MMA(0, 1, At, B1); PG8_BAR; PG8_SCHED;
            PG8_LDA(At, 1, 1); PG8_STAGE(PG8_SB(1, 0), b3, voffB); PG8_STAGE(PG8_SB(1, 1), b3 + hstepB, voffB); PG8_STAGE(PG8_SA(1, 0), a3, voffA);
            PG8_WAIT_V(8); PG8_WAIT_L(0); PG8_BAR; PG8_MMA(1, 0, At, B0); PG8_MMA(1, 1, At, B1); PG8_BAR; PG8_SCHED;
        }
        if (wr == 0) PG8_BAR;
        E(acc, cur, wr, wc, fr, fq);
        if (!has_next) break;
        if (!E.keep(cur))
#pragma unroll
        for (int a = 0; a < 2; ++a)
#pragma unroll
            for (int b = 0; b < 2; ++b)
#pragma unroll
                for (int m = 0; m < 4; ++m)
#pragma unroll
                    for (int n = 0; n < 2; ++n) acc[a][b][m][n] = (f32x4){0.f, 0.f, 0.f, 0.f};
        cur = nxt; cA = nA; cB = nB; ++ui;
        if (wr == 1) PG8_BAR;
    }
    PG8_WAIT_V(0);
    PG8_BAR;
#undef PG8_SA
#undef PG8_SB
#undef PG8_STAGE
#undef PG8_LDA
#undef PG8_LDB
#undef PG8_MMA
#undef PG8_WAIT_V
#undef PG8_WAIT_L
#undef PG8_BAR
#undef PG8_SCHED
}
}

struct EpiProj {
    bf16_t* P; const u64* rowss; u64* lnst; float* dtb; const float* dt_bias; const float* cosT; const float* sinT;
    __device__ __forceinline__ bool keep(const pg8::Unit&) const { return false; }
    template <int KIND>
    __device__ __forceinline__ void body(f32x4 (&acc)[2][2][4][2], const pg8::Unit& u, int wr, int wc, int fr, int fq) const {
        const int row0 = u.pm * 256 + wr * 64 + fr, colt = u.pn * 256 + wc * 32 + 8 * fq;
        float rsv[8];
#pragma unroll
        for (int q = 0; q < 8; ++q) rsv[q] = fx_get(rowss + row0 + (q >> 2) * 128 + (q & 3) * 16, 1.f / RSS_SCALE);
        f32x4 csn = {0.f, 0.f, 0.f, 0.f}, snn = {0.f, 0.f, 0.f, 0.f};
        if (KIND == 4) { const int pos = row0 & (SEQ - 1), i0 = 16 * wc + 4 * fq; csn = *(const f32x4*)(cosT + pos * 64 + i0); snn = *(const f32x4*)(sinT + pos * 64 + i0); }
#pragma unroll
        for (int q = 0; q < 8; ++q) {
                const int ai = q >> 2, m = q & 3;
                const int row = row0 + ai * 128 + m * 16;
                const float rs = rsqrtf(rsv[q] * (1.f / 2048.f) + 1e-6f);
                float s1 = 0.f, s2 = 0.f;
                const f32x4 cs = csn, sn = snn;
                if (KIND == 4 && q < 7) { const int pos = (row0 + ((q + 1) >> 2) * 128 + ((q + 1) & 3) * 16) & (SEQ - 1), i0 = 16 * wc + 4 * fq; csn = *(const f32x4*)(cosT + pos * 64 + i0); snn = *(const f32x4*)(sinT + pos * 64 + i0); }
#pragma unroll
                for (int bj = 0; bj < 2; ++bj) {
                    const f32x4 a0 = acc[ai][bj][m][0] * rs, a1 = acc[ai][bj][m][1] * rs;
                    float v[8] = {a0[0], a0[1], a0[2], a0[3], a1[0], a1[1], a1[2], a1[3]};
                    if (KIND == 1 || KIND == 2) {
#pragma unroll
                        for (int j = 0; j < 8; ++j) { v[j] = gelu_(v[j]); if (KIND == 2) { s1 += v[j]; s2 += v[j] * v[j]; } }
                    }
                    if (KIND == 3) {
#pragma unroll
                        for (int j = 0; j < 8; ++j) v[j] = silu_(v[j]);
                    }
                    if (KIND == 5) {
#pragma unroll
                        for (int j = 0; j < 8; ++j) v[j] = sigm(v[j]);
                    }
                    if (KIND == 4) {
                        const float sc = (u.pn < 24) ? 0.08838834764831845f : 1.f;
#pragma unroll
                        for (int i = 0; i < 4; ++i) { const float a = v[2 * i], b = v[2 * i + 1]; v[2 * i] = (a * cs[i] - b * sn[i]) * sc; v[2 * i + 1] = (b * cs[i] + a * sn[i]) * sc; }
                    }
                    if (KIND == 6) {
                        if (wc == 0 && bj == 0 && fq < 3) {
                            int fqx = fq; asm volatile("" : "+v"(fqx));
                            float o[8];
#pragma unroll
                            for (int j = 0; j < 8; ++j) { const float x = v[j] + dt_bias[8 * fqx + j]; const float e = fexp(-fabsf(x)); o[j] = fmaxf(x, 0.f) + (e < 1e-3f ? e * (1.f - e * (0.5f - e * (1.f / 3.f))) : __logf(1.f + e)); }
                            float* d = dtb + (size_t)row * 24 + 8 * fqx;
                            *(f32x4*)d = (f32x4){o[0], o[1], o[2], o[3]}; *(f32x4*)(d + 4) = (f32x4){o[4], o[5], o[6], o[7]};
                        }
                    } else {
                        *(u32x4*)(P + (size_t)row * NP + colt + bj * 128) = pack8(v);
                    }
                }
                if (KIND == 2) {
                    s1 += __shfl_xor(s1, 16); s1 += __shfl_xor(s1, 32); s2 += __shfl_xor(s2, 16); s2 += __shfl_xor(s2, 32);
                    if (fq == 0) { fx_add(lnst + 2 * row, s1, LNS_SCALE); fx_add(lnst + 2 * row + 1, s2, LNS_SCALE); }
                }
                asm volatile("" ::: "memory");
        }
    }
    __device__ __forceinline__ void operator()(f32x4 (&acc)[2][2][4][2], const pg8::Unit& u, int wr, int wc, int fr, int fq) const {
        const int pn = u.pn;
        if (pn < 6) body<1>(acc, u, wr, wc, fr, fq);
        else if (pn < 12) body<2>(acc, u, wr, wc, fr, fq);
        else if (pn < 18) body<3>(acc, u, wr, wc, fr, fq);
        else if (pn < 30) body<4>(acc, u, wr, wc, fr, fq);
        else if (pn < 36) body<0>(acc, u, wr, wc, fr, fq);
        else if (pn < 44) body<3>(acc, u, wr, wc, fr, fq);
        else if (pn < 54) body<0>(acc, u, wr, wc, fr, fq);
        else if (pn == 54) body<6>(acc, u, wr, wc, fr, fq);
        else body<5>(acc, u, wr, wc, fr, fq);
    }
};
struct EpiBranch {
    const bf16_t* P; bf16_t* MGB;
    __device__ __forceinline__ bool keep(const pg8::Unit& u) const { return u.br < 2; }
    __device__ __forceinline__ void operator()(f32x4 (&acc)[2][2][4][2], const pg8::Unit& u, int wr, int wc, int fr, int fq) const {
        const int row0 = u.pm * 256 + wr * 64 + fr, colt = u.pn * 256 + wc * 32 + 8 * fq, br = u.br;
        const bf16_t* g0 = P + C_GR + br * 2048 + colt;
        const int nb = (br < 2) ? 2048 : 0;
#pragma unroll
        for (int qq = 0; qq < 8; qq += 2) {
            u32x4 gc4[2][2], gn4[2][2];
#pragma unroll
            for (int d = 0; d < 2; ++d) { const int q = qq + d; const size_t ro = (size_t)(row0 + (q >> 2) * 128 + (q & 3) * 16) * NP;
                gc4[d][0] = *(const u32x4*)(g0 + ro); gc4[d][1] = *(const u32x4*)(g0 + ro + 128); gn4[d][0] = *(const u32x4*)(g0 + ro + nb); gn4[d][1] = *(const u32x4*)(g0 + ro + nb + 128); }
#pragma unroll
            for (int d = 0; d < 2; ++d) {
                const int q = qq + d, ai = q >> 2, m = q & 3;
#pragma unroll
                for (int bj = 0; bj < 2; ++bj) {
                    float gc[8], gn[8]; unpack8(gc4[d][bj], gc); unpack8(gn4[d][bj], gn);
                    float f[8];
#pragma unroll
                    for (int j = 0; j < 8; ++j) {
                        if (br == 0) f[j] = gc[j] * frcp(fmaxf(gn[j], 1e-20f));
                        else if (br == 1) f[j] = fmaxf(gc[j], 1e-20f) * frcp(fmaxf(gn[j], 1e-20f));
                        else f[j] = fmaxf(gc[j], 1e-20f);
                    }
                    f32x4& a0 = acc[ai][bj][m][0]; f32x4& a1 = acc[ai][bj][m][1];
                    a0 = a0 * (f32x4){f[0], f[1], f[2], f[3]}; a1 = a1 * (f32x4){f[4], f[5], f[6], f[7]};
                    if (br == 2) { const float v[8] = {a0[0], a0[1], a0[2], a0[3], a1[0], a1[1], a1[2], a1[3]}; *(u32x4*)(MGB + (size_t)(row0 + ai * 128 + m * 16) * DM + colt + bj * 128) = pack8(v); }
                }
            }
            asm volatile("" ::: "memory");
        }
    }
};
struct EpiOut {
    const float* xin; float* X32; bf16_t* XB; u64* rowss_next; int mode;
    __device__ __forceinline__ bool keep(const pg8::Unit&) const { return false; }
    __device__ __forceinline__ void operator()(f32x4 (&acc)[2][2][4][2], const pg8::Unit& u, int wr, int wc, int fr, int fq) const {
        const int row0 = u.pm * 256 + wr * 64 + fr, colt = u.pn * 256 + wc * 32 + 8 * fq;
        f32x4 nx[4], cx[4];
#define LDX(dst, q_) do { const size_t o_ = (size_t)(row0 + ((q_) >> 2) * 128 + ((q_) & 3) * 16) * DM + colt; \
        if (mode == 0) { const float* xp = xin + o_; dst[0] = *(const f32x4*)xp; dst[1] = *(const f32x4*)(xp + 4); dst[2] = *(const f32x4*)(xp + 128); dst[3] = *(const f32x4*)(xp + 132); } \
        else { const u32x4 a_ = *(const u32x4*)(XB + o_), b_ = *(const u32x4*)(XB + o_ + 128); \
               dst[0] = (f32x4){bf_lo(a_.x), bf_hi(a_.x), bf_lo(a_.y), bf_hi(a_.y)}; dst[1] = (f32x4){bf_lo(a_.z), bf_hi(a_.z), bf_lo(a_.w), bf_hi(a_.w)}; \
               dst[2] = (f32x4){bf_lo(b_.x), bf_hi(b_.x), bf_lo(b_.y), bf_hi(b_.y)}; dst[3] = (f32x4){bf_lo(b_.z), bf_hi(b_.z), bf_lo(b_.w), bf_hi(b_.w)}; } } while (0)
        LDX(nx, 0);
#pragma unroll
        for (int q = 0; q < 8; ++q) {
            const int ai = q >> 2, m = q & 3;
            const int row = row0 + ai * 128 + m * 16; float ss = 0.f;
            cx[0] = nx[0]; cx[1] = nx[1]; cx[2] = nx[2]; cx[3] = nx[3];
            if (q < 7) LDX(nx, q + 1);
#pragma unroll
            for (int bj = 0; bj < 2; ++bj) {
                const size_t off = (size_t)row * DM + colt + bj * 128;
                const f32x4 x0 = cx[2 * bj] + acc[ai][bj][m][0], x1 = cx[2 * bj + 1] + acc[ai][bj][m][1];
                if (mode == 2) { *(f32x4*)(X32 + off) = x0; *(f32x4*)(X32 + off + 4) = x1; }
                else { u32x4 w; w.x = pk_bf16(x0[0], x0[1]); w.y = pk_bf16(x0[2], x0[3]); w.z = pk_bf16(x1[0], x1[1]); w.w = pk_bf16(x1[2], x1[3]); *(u32x4*)(XB + off) = w; }
                ss += (x0[0] * x0[0] + x0[1] * x0[1]) + (x0[2] * x0[2] + x0[3] * x0[3]) + (x1[0] * x1[0] + x1[1] * x1[1]) + (x1[2] * x1[2] + x1[3] * x1[3]);
            }
            ss += __shfl_xor(ss, 16); ss += __shfl_xor(ss, 32);
            if (fq == 0) fx_add(rowss_next + row, ss, RSS_SCALE);
            asm volatile("" ::: "memory");
        }
#undef LDX
    }
};

struct Params { const float* in[18]; float* out; unsigned char* ws; int ph_lo, ph_hi; };
struct Ctx {
    const float *x, *norm_w, *w_in, *ln_w, *ln_b, *gws, *gbs, *conv_w, *conv_b, *dt_bias, *a_log, *d_skip, *ssm_nw, *wa, *wb, *wc, *wout, *fnw;
    float* out; unsigned char* ws;
    u64 *rowss, *lnst; float *cosT, *sinT, *dtb, *cum, *cdec, *lse, *X32, *MG32;
    bf16_t *WIN, *WBR, *WOUT, *XB, *P, *XCV, *ST, *OG, *Y, *MGB, *PREV;
};

__device__ __forceinline__ int win_dst_row(int sc) {
    if (sc >= NIN) return -1;
    if (sc >= C_Q && sc < C_VV) { const int off = sc - C_Q, hd = off >> 7, i = off & 127; return C_Q + hd * 128 + (i < 64 ? 2 * i : 2 * (i - 64) + 1); }
    if (sc < 13848) return sc;
    return sc + 232;
}
template <bool WIN>
__device__ __forceinline__ void transpose_item(const float* W, int Nsrc, bf16_t* WT, int ldt, int koff, const float* kscale, LAS float* scr, int kb, int nb, int lane) {
    const int k0 = 64 * kb, n0 = 32 * nb;
    const int ks = lane >> 3, c4 = lane & 7;
    const bool cok = (n0 + 4 * c4 + 3) < Nsrc;
    f32x4 v[8];
#pragma unroll
    for (int i = 0; i < 8; ++i) v[i] = cok ? *(const f32x4*)(W + (size_t)(k0 + 8 * i + ks) * Nsrc + n0 + 4 * c4) : (f32x4){0.f, 0.f, 0.f, 0.f};
#pragma unroll
    for (int i = 0; i < 8; ++i) { const int kk = 8 * i + ks; f32x4 x = v[i]; if (WIN) x = x * kscale[k0 + kk]; LAS float* d = scr + kk * 33 + 4 * c4; d[0] = x[0]; d[1] = x[1]; d[2] = x[2]; d[3] = x[3]; }
    LDS_WAIT();
    const int c = lane & 7;
#pragma unroll
    for (int j = 0; j < 4; ++j) { const int n = (lane >> 3) + 8 * j; const LAS float* p = scr + (8 * c) * 33 + n;
        u32x4 o; o.x = pk_bf16(p[0 * 33], p[1 * 33]); o.y = pk_bf16(p[2 * 33], p[3 * 33]); o.z = pk_bf16(p[4 * 33], p[5 * 33]); o.w = pk_bf16(p[6 * 33], p[7 * 33]);
        const int dr = WIN ? win_dst_row(n0 + n) : n0 + n;
        if (dr >= 0) *(u32x4*)(WT + (size_t)dr * ldt + koff + k0 + 8 * c) = o; }
    LDS_WAIT();
}
__device__ __forceinline__ void phase_prologue(const Ctx& C, LAS unsigned char* lds) {
    int tid = threadIdx.x; asm volatile("" : "+v"(tid));
    const int lane = tid & 63, wave = tid >> 6;
    const int gw = blockIdx.x * 8 + wave, NGW = gridDim.x * 8;
    const int gt = blockIdx.x * 512 + tid, NGT = gridDim.x * 512;
    if (blockIdx.x == 0) for (int i = tid; i < 4096; i += 512) ((unsigned*)(C.ws + WS_BAR))[i] = 0u;
    for (int i = gt; i < 4 * MTOK; i += NGT) C.rowss[MTOK + i] = 0ull;
    for (int i = gt; i < 8 * MTOK; i += NGT) C.lnst[i] = 0ull;
    for (int i = gt; i < SEQ * 64; i += NGT) { const int pos = i >> 6, k = i & 63; const float inv = 1.0f / powf(10000.0f, (float)(2 * k) / 128.0f); const float ang = (float)pos * inv; C.cosT[i] = cosf(ang); C.sinT[i] = sinf(ang); }
    for (int m = gw; m < MTOK; m += NGW) {
        const f32x4* xr = (const f32x4*)(C.x + (size_t)m * DM) + lane; float s = 0.f;
        u32x2* o = (u32x2*)(C.XB + (size_t)m * DM) + lane;
#pragma unroll
        for (int j = 0; j < 8; ++j) { const f32x4 v = xr[64 * j]; s += (v[0] * v[0] + v[1] * v[1]) + (v[2] * v[2] + v[3] * v[3]); u32x2 w; w.x = pk_bf16(v[0], v[1]); w.y = pk_bf16(v[2], v[3]); o[64 * j] = w; }
#pragma unroll
        for (int of = 1; of < 64; of <<= 1) s += __shfl_xor(s, of);
        if (lane == 0) C.rowss[m] = (u64)(long long)__float2ll_rn(s * RSS_SCALE);
    }
    LAS float* scr = (LAS float*)(lds + wave * 16384);
    constexpr int NBIN = (NIN + 31) / 32, I_IN = 32 * NBIN, I_A = 24 * 64, I_B = 8 * 64, I_O = 32 * 64, I_L = I_IN + 2 * I_A + I_B + I_O;
    for (int i = gt; i < NLAYER * 232 * 256; i += NGT) { const int l = i / (232 * 256), r = i % (232 * 256); *(u32x4*)(C.WIN + ((size_t)l * NP + 13848 + (r >> 8)) * DM + (r & 255) * 8) = (u32x4){0u, 0u, 0u, 0u}; }
    for (int it = gw; it < NLAYER * I_L; it += NGW) {
        const int l = it / I_L; int r = it - l * I_L;
        if (r < I_IN) { transpose_item<true>(C.w_in + (size_t)l * DM * NIN, NIN, C.WIN + (size_t)l * NP * DM, DM, 0, C.norm_w + l * DM, scr, r / NBIN, r % NBIN, lane); continue; } r -= I_IN;
        bf16_t* wbr = C.WBR + (size_t)l * DM * KBR;
        if (r < I_A) { transpose_item<false>(C.wa + (size_t)l * 1536 * DM, DM, wbr, KBR, 0, nullptr, scr, r / 64, r % 64, lane); continue; } r -= I_A;
        if (r < I_B) { transpose_item<false>(C.wb + (size_t)l * 512 * DM, DM, wbr, KBR, 1536, nullptr, scr, r / 64, r % 64, lane); continue; } r -= I_B;
        if (r < I_A) { transpose_item<false>(C.wc + (size_t)l * 1536 * DM, DM, wbr, KBR, 2048, nullptr, scr, r / 64, r % 64, lane); continue; } r -= I_A;
        transpose_item<false>(C.wout + (size_t)l * DM * DM, DM, C.WOUT + (size_t)l * DM * DM, DM, 0, nullptr, scr, r / 64, r % 64, lane);
    }
}

__device__ __forceinline__ void gmlp_item(const Ctx& C, int layer, int item, LAS unsigned char* lds) {
    int tid = threadIdx.x; asm volatile("" : "+v"(tid));
    const int w = __builtin_amdgcn_readfirstlane(tid >> 6), lane = tid & 63, fr = lane & 15, fq = lane >> 4;
    const int b = item / 192, c = (item / 12) % 16, g = item % 12;
    const int row0 = b * SEQ + 128 * c;
    LAS unsigned char* WS = lds; LAS unsigned char* VT = lds + 34816;
    const float* Wg = C.gws + ((size_t)(layer * 12 + g)) * 128 * 128;
    const u64* lnst = C.lnst + (size_t)layer * MTOK * 2;
    const float* lw = C.ln_w + layer * 1536 + g * 128; const float* lb = C.ln_b + layer * 1536 + g * 128;
    const int t = 16 * w + fr, row = row0 + t;
    const float bs = C.gbs[(layer * 12 + g) * 128 + t];
    u32x2 uu8[8], zz8[8];
#pragma unroll
    for (int e = 0; e < 8; ++e) { const int col = g * 128 + 16 * e + 4 * fq; uu8[e] = *(const u32x2*)(C.P + (size_t)row * NP + C_U + col); zz8[e] = *(const u32x2*)(C.P + (size_t)row * NP + C_ZA + col); }
#pragma unroll
    for (int idx = tid; idx < 2048; idx += 512) {
        const int t = idx >> 4, ch = idx & 15;
        const f32x4 w0 = *(const f32x4*)(Wg + t * 128 + ch * 8), w1 = *(const f32x4*)(Wg + t * 128 + ch * 8 + 4);
        float v[8] = {w0[0], w0[1], w0[2], w0[3], w1[0], w1[1], w1[2], w1[3]};
#pragma unroll
        for (int j = 0; j < 8; ++j) if (ch * 8 + j > t) v[j] = 0.f;
        *(LAS u32x4*)(WS + t * 272 + ch * 16) = pack8(v);
        const int row = row0 + t;
        const float mu = fx_get(lnst + 2 * row, 1.f / LNS_SCALE) * (1.f / 1536.f), var = fx_get(lnst + 2 * row + 1, 1.f / LNS_SCALE) * (1.f / 1536.f) - mu * mu, rstd = rsqrtf(fmaxf(var, 0.f) + 1e-5f);
        float x[8]; unpack8(*(const u32x4*)(C.P + (size_t)row * NP + C_V + g * 128 + ch * 8), x);
        const f32x4 g0 = *(const f32x4*)(lw + ch * 8), g1 = *(const f32x4*)(lw + ch * 8 + 4), b0 = *(const f32x4*)(lb + ch * 8), b1 = *(const f32x4*)(lb + ch * 8 + 4);
        const float gw[8] = {g0[0], g0[1], g0[2], g0[3], g1[0], g1[1], g1[2], g1[3]}, gb[8] = {b0[0], b0[1], b0[2], b0[3], b1[0], b1[1], b1[2], b1[3]};
        LAS bf16_t* vt = (LAS bf16_t*)VT + (ch * 8) * 136 + swz(ch * 8, t);
#pragma unroll
        for (int j = 0; j < 8; ++j) { const float y = (x[j] - mu) * rstd * gw[j] + gb[j]; vt[j * 136] = (bf16_t)(pk_bf16(y, 0.f) & 0xffffu); }
    }
    __syncthreads();
    f32x4 acc[8];
#pragma unroll
    for (int e = 0; e < 8; ++e) acc[e] = (f32x4){0.f, 0.f, 0.f, 0.f};
    const int ksmax = w >> 1;
    for (int ks = 0; ks <= ksmax; ++ks) {
        const bf16x8 wf = ldsfrag(WS + (16 * w + fr) * 272 + (32 * ks + 8 * fq) * 2);
#pragma unroll
        for (int e = 0; e < 8; ++e) { const bf16x8 vf = ldsfrag(VT + (16 * e + fr) * 272 + swz(16 * e + fr, 32 * ks + 8 * fq) * 2); acc[e] = MFMA16(vf, wf, acc[e]); }
    }
#pragma unroll
    for (int e = 0; e < 8; ++e) {
        const int col = g * 128 + 16 * e + 4 * fq;
        const u32x2 uu = uu8[e], zz = zz8[e];
        u32x2 o; o.x = pk_bf16(bf_lo(uu.x) * (acc[e][0] + bs) * bf_lo(zz.x), bf_hi(uu.x) * (acc[e][1] + bs) * bf_hi(zz.x));
        o.y = pk_bf16(bf_lo(uu.y) * (acc[e][2] + bs) * bf_lo(zz.y), bf_hi(uu.y) * (acc[e][3] + bs) * bf_hi(zz.y));
        *(u32x2*)(C.Y + (size_t)row * KBR + col) = o;
    }
    __syncthreads();
}

__device__ __forceinline__ void attn_item(const Ctx& C, int item, LAS unsigned char* lds) {
    int tid = threadIdx.x; asm volatile("" : "+v"(tid));
    const int w = __builtin_amdgcn_readfirstlane(tid >> 6), lane = tid & 63, fr = lane & 15, fq = lane >> 4;
    const int grp = item >> 8, r = item & 255, b = r >> 6, j = (r >> 4) & 3;
    int d, cls, qb;
    if (grp == 0) { d = 1; cls = 0; qb = r & 15; } else if (grp == 1) { d = 4; cls = (r >> 2) & 3; qb = r & 3; } else { d = 16; cls = r & 15; qb = 0; }
    const int head = grp * 4 + j;
    LAS unsigned char* KS = lds; LAS unsigned char* VT = lds + 69632;
    const bf16_t* Pq = C.P + C_Q + head * 128; const bf16_t* Pk = C.P + C_K + head * 128; const bf16_t* Pv = C.P + C_VV + head * 128;
#pragma unroll
    for (int idx = tid; idx < 4096; idx += 512) {
        const int kk = idx >> 4, ch = idx & 15, n = 128 * (qb - 1) + kk;
        if (qb == 0 && idx < 2048) continue;
        u32x4 kv = {0u, 0u, 0u, 0u}, vv = {0u, 0u, 0u, 0u};
        if (n >= 0) { const size_t row = (size_t)b * SEQ + d * n + cls; kv = *(const u32x4*)(Pk + row * NP + ch * 8); vv = *(const u32x4*)(Pv + row * NP + ch * 8); }
        *(LAS u32x4*)(KS + kk * 272 + ch * 16) = kv;
        LAS bf16_t* vt = (LAS bf16_t*)VT + (ch * 8) * 264 + swz(ch * 8, kk);
        vt[0 * 264] = (bf16_t)(vv.x & 0xffffu); vt[1 * 264] = (bf16_t)(vv.x >> 16); vt[2 * 264] = (bf16_t)(vv.y & 0xffffu); vt[3 * 264] = (bf16_t)(vv.y >> 16);
        vt[4 * 264] = (bf16_t)(vv.z & 0xffffu); vt[5 * 264] = (bf16_t)(vv.z >> 16); vt[6 * 264] = (bf16_t)(vv.w & 0xffffu); vt[7 * 264] = (bf16_t)(vv.w >> 16);
    }
    const int qi = 16 * w + fr;
    const size_t rowq = (size_t)b * SEQ + d * (128 * qb + qi) + cls;
    bf16x8 qf[4];
#pragma unroll
    for (int ks = 0; ks < 4; ++ks) qf[ks] = *(const bf16x8*)(Pq + rowq * NP + ks * 32 + fq * 8);
    __syncthreads();
    const int lo = (qb > 0) ? w : (w > 8 ? w : 8), hi = w + 8;
    f32x4 S[16];
    float mx = -INFINITY;
#pragma unroll
    for (int kt = 0; kt < 16; ++kt) {
        S[kt] = (f32x4){-INFINITY, -INFINITY, -INFINITY, -INFINITY};
        if (kt >= lo && kt <= hi) {
            f32x4 a = {0.f, 0.f, 0.f, 0.f};
#pragma unroll
            for (int ks = 0; ks < 4; ++ks) a = MFMA16(ldsfrag(KS + (16 * kt + fr) * 272 + (32 * ks + 8 * fq) * 2), qf[ks], a);
#pragma unroll
            for (int rr = 0; rr < 4; ++rr) { const int kk = 16 * kt + 4 * fq + rr, dist = 128 + qi - kk; const bool ok = dist >= 0 && dist <= 128 && (qb > 0 || kk >= 128); const float s = ok ? a[rr] : -INFINITY; S[kt][rr] = s; mx = fmaxf(mx, s); }
        }
    }
    mx = fmaxf(mx, __shfl_xor(mx, 16)); mx = fmaxf(mx, __shfl_xor(mx, 32));
    float sum = 0.f;
#pragma unroll
    for (int kt = 0; kt < 16; ++kt)
#pragma unroll
        for (int rr = 0; rr < 4; ++rr) { const float p = fexp(S[kt][rr] - mx); S[kt][rr] = p; sum += p; }
    sum += __shfl_xor(sum, 16); sum += __shfl_xor(sum, 32);
    const float inv = 1.f / sum;
    bf16x8 pf[8];
#pragma unroll
    for (int u = 0; u < 8; ++u) { u32x4 t; t.x = pk_bf16(S[2 * u][0], S[2 * u][1]); t.y = pk_bf16(S[2 * u][2], S[2 * u][3]); t.z = pk_bf16(S[2 * u + 1][0], S[2 * u + 1][1]); t.w = pk_bf16(S[2 * u + 1][2], S[2 * u + 1][3]); pf[u] = __builtin_bit_cast(bf16x8, t); }
    bf16_t* og = C.OG + ((size_t)grp * MTOK + rowq) * 512 + j * 128;
#pragma unroll
    for (int et = 0; et < 8; ++et) {
        f32x4 a = {0.f, 0.f, 0.f, 0.f};
#pragma unroll
        for (int u = 0; u < 8; ++u) if (2 * u + 1 >= lo && 2 * u <= hi) {
            const LAS unsigned char* vr = VT + (16 * et + fr) * 528;
            a = MFMA16(frag2(*(const LAS u32x2*)(vr + swz(16 * et + fr, 32 * u + 4 * fq) * 2), *(const LAS u32x2*)(vr + swz(16 * et + fr, 32 * u + 16 + 4 * fq) * 2)), pf[u], a);
        }
        u32x2 o; o.x = pk_bf16(a[0] * inv, a[1] * inv); o.y = pk_bf16(a[2] * inv, a[3] * inv);
        *(u32x2*)(og + 16 * et + 4 * fq) = o;
    }
    if (fq == 0) C.lse[((size_t)grp * MTOK + rowq) * 4 + j] = mx + logf(sum);
    __syncthreads();
}

__device__ __forceinline__ void ssd1_item(const Ctx& C, int layer, int item, LAS unsigned char* lds) {
    int tid = threadIdx.x; asm volatile("" : "+v"(tid));
    const int w = __builtin_amdgcn_readfirstlane(tid >> 6), lane = tid & 63, fr = lane & 15, fq = lane >> 4;
    const int b = item >> 6, c = (item >> 2) & 15, g = item & 3;
    const int row0 = b * SEQ + 128 * c;
    LAS unsigned char* XT = lds; LAS unsigned char* BT = lds + 104448;
    LAS float* cumS = (LAS float*)(lds + 139264); LAS float* wS = (LAS float*)(lds + 142336);
    if (w < 6) {
        const int h = 6 * g + w, l0 = 2 * lane;
        const float dt0 = C.dtb[(size_t)(row0 + l0) * 24 + h], dt1 = C.dtb[(size_t)(row0 + l0 + 1) * 24 + h];
        const float a = -expf(C.a_log[layer * 24 + h]);
        const float da0 = dt0 * a, da1 = dt1 * a; float s = da0 + da1;
#pragma unroll
        for (int o = 1; o < 64; o <<= 1) { const float t = __shfl_up(s, o); if (lane >= o) s += t; }
        const float c1 = s, c0 = s - da1, last = __shfl(s, 63);
        cumS[w * 128 + l0] = c0; cumS[w * 128 + l0 + 1] = c1;
        C.cum[(size_t)(row0 + l0) * 24 + h] = c0; C.cum[(size_t)(row0 + l0 + 1) * 24 + h] = c1;
        wS[w * 128 + l0] = dt0 * expf(last - c0); wS[w * 128 + l0 + 1] = dt1 * expf(last - c1);
        if (lane == 0) C.cdec[(b * 16 + c) * 24 + h] = expf(last);
    }
    __syncthreads();
    const float* cw = C.conv_w + (size_t)layer * 4 * 2560; const float* cbv = C.conv_b + (size_t)layer * 2560;
#pragma unroll 4
    for (int idx = tid; idx < 128 * 80; idx += 512) {
        const int s = (idx >> 4) & 127, ch8 = (idx >> 11) * 16 + (idx & 15);
        const int cb = ch8 < 48 ? 384 * g + 8 * ch8 : (ch8 < 64 ? 1536 + 128 * g + 8 * (ch8 - 48) : 2048 + 128 * g + 8 * (ch8 - 64));
        const f32x4 bb0 = *(const f32x4*)(cbv + cb), bb1 = *(const f32x4*)(cbv + cb + 4);
        float o[8] = {bb0[0], bb0[1], bb0[2], bb0[3], bb1[0], bb1[1], bb1[2], bb1[3]};
#pragma unroll
        for (int t = 0; t < 4; ++t) {
            const int tok = 128 * c + s - 3 + t;
            if (tok >= 0) {
                float x[8]; unpack8(*(const u32x4*)(C.P + (size_t)(b * SEQ + tok) * NP + C_XBC + cb), x);
                const f32x4 k0 = *(const f32x4*)(cw + t * 2560 + cb), k1 = *(const f32x4*)(cw + t * 2560 + cb + 4);
                o[0] += k0[0] * x[0]; o[1] += k0[1] * x[1]; o[2] += k0[2] * x[2]; o[3] += k0[3] * x[3]; o[4] += k1[0] * x[4]; o[5] += k1[1] * x[5]; o[6] += k1[2] * x[6]; o[7] += k1[3] * x[7];
            }
        }
#pragma unroll
        for (int jj = 0; jj < 8; ++jj) o[jj] = silu_(o[jj]);
        *(u32x4*)(C.XCV + (size_t)(row0 + s) * 2560 + cb) = pack8(o);
        if (ch8 < 48) {
            const float sc = wS[(ch8 >> 3) * 128 + s];
            LAS bf16_t* xt = (LAS bf16_t*)XT + (ch8 * 8) * 136 + swz(ch8 * 8, s);
#pragma unroll
            for (int jj = 0; jj < 8; ++jj) xt[jj * 136] = (bf16_t)(pk_bf16(o[jj] * sc, 0.f) & 0xffffu);
        } else if (ch8 < 64) {
            LAS bf16_t* bt = (LAS bf16_t*)BT + ((ch8 - 48) * 8) * 136 + swz((ch8 - 48) * 8, s);
#pragma unroll
            for (int jj = 0; jj < 8; ++jj) bt[jj * 136] = (bf16_t)(pk_bf16(o[jj], 0.f) & 0xffffu);
        }
    }
    __syncthreads();
#ifndef DBG_NO_STATES
    for (int pi = 0; pi < 3; ++pi) {
        const int pt = 3 * w + pi, hh = pt >> 2, p = (pt & 3) * 16 + fr;
        bf16x8 xf[4];
#pragma unroll
        for (int ks = 0; ks < 4; ++ks) xf[ks] = ldsfrag(XT + (16 * pt + fr) * 272 + swz(16 * pt + fr, 32 * ks + 8 * fq) * 2);
        bf16_t* st = C.ST + ((size_t)((b * 16 + c) * 24 + 6 * g + hh) * 64 + p) * 128;
#pragma unroll
        for (int nt = 0; nt < 8; ++nt) {
            f32x4 a = {0.f, 0.f, 0.f, 0.f};
#pragma unroll
            for (int ks = 0; ks < 4; ++ks) a = MFMA16(ldsfrag(BT + (16 * nt + fr) * 272 + swz(16 * nt + fr, 32 * ks + 8 * fq) * 2), xf[ks], a);
            u32x2 o; o.x = pk_bf16(a[0], a[1]); o.y = pk_bf16(a[2], a[3]);
            *(u32x2*)(st + 16 * nt + 4 * fq) = o;
        }
    }
#endif
    __syncthreads();
}

__device__ __forceinline__ void ssd2_item(const Ctx& C, int layer, int item, LAS unsigned char* lds) {
    int tid = threadIdx.x; asm volatile("" : "+v"(tid));
    const int w = __builtin_amdgcn_readfirstlane(tid >> 6), lane = tid & 63, fr = lane & 15, fq = lane >> 4;
    const int b = item >> 6, c = (item >> 2) & 15, g = item & 3;
    const int row0 = b * SEQ + 128 * c;
    LAS unsigned char* XT = lds; LAS unsigned char* BM = lds + 104448;
    LAS float* cumS = (LAS float*)(lds + 139264); LAS float* dtS = (LAS float*)(lds + 142336);
    const int t = 16 * w + fr, row = row0 + t;
    bf16x8 cf[4];
#pragma unroll
    for (int ks = 0; ks < 4; ++ks) cf[ks] = *(const bf16x8*)(C.XCV + (size_t)row * 2560 + 2048 + 128 * g + 32 * ks + 8 * fq);
    for (int idx = tid; idx < 768; idx += 512) { const int hh = idx >> 7, l = idx & 127; cumS[idx] = C.cum[(size_t)(row0 + l) * 24 + 6 * g + hh]; dtS[idx] = C.dtb[(size_t)(row0 + l) * 24 + 6 * g + hh]; }
#pragma unroll
    for (int idx = tid; idx < 2048; idx += 512) { const int s = idx >> 4, ch = idx & 15; *(LAS u32x4*)(BM + s * 272 + ch * 16) = *(const u32x4*)(C.XCV + (size_t)(row0 + s) * 2560 + 1536 + 128 * g + 8 * ch); }
    __syncthreads();
#pragma unroll 4
    for (int idx = tid; idx < 128 * 48; idx += 512) {
        const int s = (idx >> 4) & 127, ch8 = (idx >> 11) * 16 + (idx & 15);
        float x[8]; unpack8(*(const u32x4*)(C.XCV + (size_t)(row0 + s) * 2560 + 384 * g + 8 * ch8), x);
        const float sc = dtS[(ch8 >> 3) * 128 + s];
        LAS bf16_t* xt = (LAS bf16_t*)XT + (ch8 * 8) * 136 + swz(ch8 * 8, s);
#pragma unroll
        for (int jj = 0; jj < 8; ++jj) xt[jj * 136] = (bf16_t)(pk_bf16(x[jj] * sc, 0.f) & 0xffffu);
    }
    f32x4 cbt[8];
#pragma unroll
    for (int st = 0; st < 8; ++st) {
        cbt[st] = (f32x4){0.f, 0.f, 0.f, 0.f};
        if (st <= w) {
#pragma unroll
            for (int ks = 0; ks < 4; ++ks) cbt[st] = MFMA16(ldsfrag(BM + (16 * st + fr) * 272 + (32 * ks + 8 * fq) * 2), cf[ks], cbt[st]);
        }
    }
    __syncthreads();
    float ss = 0.f;
    const int pp = tid >> 3, n0 = (tid & 7) * 16;
    u32x4 nq0, nq1;
    { const bf16_t* sp = C.PREV + ((size_t)((b * 16 + c) * 24 + 6 * g) * 64 + pp) * 128 + n0; nq0 = *(const u32x4*)sp; nq1 = *(const u32x4*)(sp + 8); }
#pragma unroll 1
    for (int hh = 0; hh < 6; ++hh) {
        const int h = 6 * g + hh;
        LAS unsigned char* PV = BM + (hh & 1) * 17408;
        {
            *(LAS u32x4*)(PV + pp * 272 + n0 * 2) = nq0; *(LAS u32x4*)(PV + pp * 272 + n0 * 2 + 16) = nq1;
            if (hh < 5) { const bf16_t* sp = C.PREV + ((size_t)((b * 16 + c) * 24 + h + 1) * 64 + pp) * 128 + n0; nq0 = *(const u32x4*)sp; nq1 = *(const u32x4*)(sp + 8); }
        }
        u32x2 xx4[4], zz4[4];
#pragma unroll
        for (int pt = 0; pt < 4; ++pt) { const int ch = 384 * g + 64 * hh + 16 * pt + 4 * fq; xx4[pt] = *(const u32x2*)(C.XCV + (size_t)row * 2560 + ch); zz4[pt] = *(const u32x2*)(C.P + (size_t)row * NP + C_ZC + ch); }
        __syncthreads();
        const float cum_t = cumS[hh * 128 + t], e_t = expf(cum_t), dsk = C.d_skip[layer * 24 + h];
        bf16x8 gf[4];
#pragma unroll
        for (int u = 0; u < 4; ++u) {
            const f32x4 ca = *(const LAS f32x4*)(cumS + hh * 128 + 32 * u + 4 * fq), cb2 = *(const LAS f32x4*)(cumS + hh * 128 + 32 * u + 16 + 4 * fq);
            float gv[8];
#pragma unroll
            for (int rr = 0; rr < 4; ++rr) {
                const int s0 = 32 * u + 4 * fq + rr, s1 = s0 + 16;
                gv[rr] = (s0 <= t) ? cbt[2 * u][rr] * expf(cum_t - ca[rr]) : 0.f;
                gv[4 + rr] = (s1 <= t) ? cbt[2 * u + 1][rr] * expf(cum_t - cb2[rr]) : 0.f;
            }
            gf[u] = __builtin_bit_cast(bf16x8, pack8(gv));
        }
#pragma unroll
        for (int pt = 0; pt < 4; ++pt) {
            f32x4 ao = {0.f, 0.f, 0.f, 0.f}, ad = {0.f, 0.f, 0.f, 0.f};
#pragma unroll
            for (int ks = 0; ks < 4; ++ks) ao = MFMA16(ldsfrag(PV + (16 * pt + fr) * 272 + (32 * ks + 8 * fq) * 2), cf[ks], ao);
#pragma unroll
            for (int u = 0; u < 4; ++u) if (u <= (w >> 1)) {
                const int xrow = 64 * hh + 16 * pt + fr; const LAS unsigned char* xr = XT + xrow * 272;
                ad = MFMA16(frag2(*(const LAS u32x2*)(xr + swz(xrow, 32 * u + 4 * fq) * 2), *(const LAS u32x2*)(xr + swz(xrow, 32 * u + 16 + 4 * fq) * 2)), gf[u], ad);
            }
            const int ch = 384 * g + 64 * hh + 16 * pt + 4 * fq;
            const u32x2 xx = xx4[pt], zz = zz4[pt];
            const float y0 = (ad[0] + e_t * ao[0] + dsk * bf_lo(xx.x)) * bf_lo(zz.x), y1 = (ad[1] + e_t * ao[1] + dsk * bf_hi(xx.x)) * bf_hi(zz.x);
            const float y2 = (ad[2] + e_t * ao[2] + dsk * bf_lo(xx.y)) * bf_lo(zz.y), y3 = (ad[3] + e_t * ao[3] + dsk * bf_hi(xx.y)) * bf_hi(zz.y);
            ss += (y0 * y0 + y1 * y1) + (y2 * y2 + y3 * y3);
            u32x2 yo; yo.x = pk_bf16(y0, y1); yo.y = pk_bf16(y2, y3); *(u32x2*)(C.Y + (size_t)row * KBR + 2048 + ch) = yo;
        }
    }
    ss += __shfl_xor(ss, 16); ss += __shfl_xor(ss, 32);
    const float rstd = rsqrtf(ss * (1.f / 384.f) + 1e-5f);
    const float* nw = C.ssm_nw + layer * 1536;
#pragma unroll 2
    for (int q = 0; q < 24; ++q) {
            const int ch = 384 * g + 16 * q + 4 * fq;
            const f32x4 nv = *(const f32x4*)(nw + ch);
            u32x2* yp = (u32x2*)(C.Y + (size_t)row * KBR + 2048 + ch); const u32x2 yy = *yp;
            u32x2 o; o.x = pk_bf16(bf_lo(yy.x) * rstd * nv[0], bf_hi(yy.x) * rstd * nv[1]); o.y = pk_bf16(bf_lo(yy.y) * rstd * nv[2], bf_hi(yy.y) * rstd * nv[3]);
            *yp = o;
        }
    __syncthreads();
}
__device__ __forceinline__ void scan_states(const Ctx& C) {
    int tid = threadIdx.x; asm volatile("" : "+v"(tid));
    const int gt = blockIdx.x * 512 + tid, NGT = gridDim.x * 512;
    for (int task = gt; task < 96 * 1024; task += NGT) {
        const int bh = task >> 10, e8 = task & 1023, b = bh / 24, h = bh - 24 * b;
        u32x4 v[15]; float d[15];
#pragma unroll
        for (int c = 0; c < 15; ++c) { v[c] = *(const u32x4*)(C.ST + (size_t)((b * 16 + c) * 24 + h) * 8192 + e8 * 8); d[c] = C.cdec[(b * 16 + c) * 24 + h]; }
        float car[8] = {0.f, 0.f, 0.f, 0.f, 0.f, 0.f, 0.f, 0.f};
#pragma unroll
        for (int c = 0; c < 16; ++c) {
            *(u32x4*)(C.PREV + (size_t)((b * 16 + c) * 24 + h) * 8192 + e8 * 8) = pack8(car);
            if (c < 15) { float sv[8]; unpack8(v[c], sv);
#pragma unroll
                for (int i = 0; i < 8; ++i) car[i] = car[i] * d[c] + sv[i]; }
        }
    }
}
__device__ __forceinline__ void combine_item(const Ctx& C, int item) {
    int tid = threadIdx.x; asm volatile("" : "+v"(tid));
#pragma unroll
    for (int idx = tid; idx < 32 * 64; idx += 512) {
        const int row = item * 32 + (idx >> 6), chunk = idx & 63, j = chunk >> 4;
        const float l0 = C.lse[((size_t)0 * MTOK + row) * 4 + j], l1 = C.lse[((size_t)1 * MTOK + row) * 4 + j], l2 = C.lse[((size_t)2 * MTOK + row) * 4 + j];
        const float m = fmaxf(l0, fmaxf(l1, l2)); float w0 = expf(l0 - m), w1 = expf(l1 - m), w2 = expf(l2 - m); const float iv = 1.f / (w0 + w1 + w2); w0 *= iv; w1 *= iv; w2 *= iv;
        float a0[8], a1[8], a2[8], z[8];
        unpack8(*(const u32x4*)(C.OG + ((size_t)0 * MTOK + row) * 512 + chunk * 8), a0); unpack8(*(const u32x4*)(C.OG + ((size_t)1 * MTOK + row) * 512 + chunk * 8), a1);
        unpack8(*(const u32x4*)(C.OG + ((size_t)2 * MTOK + row) * 512 + chunk * 8), a2); unpack8(*(const u32x4*)(C.P + (size_t)row * NP + C_ZB + chunk * 8), z);
        float o[8];
#pragma unroll
        for (int i = 0; i < 8; ++i) o[i] = (w0 * a0[i] + w1 * a1[i] + w2 * a2[i]) * z[i];
        *(u32x4*)(C.Y + (size_t)row * KBR + 1536 + chunk * 8) = pack8(o);
    }
}


#ifdef DBG_LAST
__device__ __forceinline__ float dbg_bf(const bf16_t* p, size_t i) { return __uint_as_float(((unsigned)p[i]) << 16); }
__global__ void __launch_bounds__(512) dbg_dump(Ctx C) {
    const size_t NO = (size_t)MTOK * DM;
    for (size_t i = (size_t)blockIdx.x * 512 + threadIdx.x; i < NO; i += (size_t)gridDim.x * 512) {
        float v = 0.f;
#if DBG_MASK & 1
        { const size_t row = i / DM, c = i % DM; for (int j = 0; j < 10; ++j) { const size_t cc = c + (size_t)j * DM; if (cc < NP && !(cc >= 13848 && cc < C_GR)) v += dbg_bf(C.P, row * NP + cc); }
          if (c < 24) v += C.dtb[row * 24 + c]; v += dbg_bf(C.XB, i); }
#endif
#if DBG_MASK & 2
        { const size_t row = i / DM, c = i % DM; if (c < 1536) v += dbg_bf(C.Y, row * KBR + c); v += dbg_bf(C.XCV, row * 2560 + c); if (c < 512) v += dbg_bf(C.XCV, row * 2560 + 2048 + c);
          if (i < (size_t)3 * MTOK * 512) v += dbg_bf(C.OG, i); if (i < (size_t)3 * MTOK * 4) v += C.lse[i]; if (i < (size_t)4 * 16 * 24 * 64 * 128) v += dbg_bf(C.ST, i);
          if (c < 24) v += C.cum[row * 24 + c]; if (i < 4 * 16 * 24) v += C.cdec[i]; }
#endif
#if DBG_MASK & 4
        { const size_t row = i / DM, c = i % DM; v += dbg_bf(C.Y, row * KBR + c); if (c < 1536) v += dbg_bf(C.Y, row * KBR + 2048 + c); }
#endif
#if DBG_MASK & 8
        v += dbg_bf(C.MGB, i);
#endif
#if DBG_MASK & 16
        v += C.X32[i];
#endif
        C.out[i] = v;
    }
}
#endif
__device__ __forceinline__ const float* ldp(const float** t, int i) {
    const unsigned long long v = (unsigned long long)t[i];
    const unsigned lo = __builtin_amdgcn_readfirstlane((unsigned)v), hi = __builtin_amdgcn_readfirstlane((unsigned)(v >> 32));
    return (const float*)(((unsigned long long)hi << 32) | lo);
}
#define XB_TMO      128
#define XB_XCNT(j)  (256  + 64 * (j))
#define XB_XSUB(j)  (1280 + 64 * (j))
#define XB_XGEN(j)  (2304 + 64 * (j))
#define XB_TOP      3328
#define XB_TOPGEN   3392
#define XCD_BAR_WORDS 3456
#define XB_SPIN_CAP (1u << 18)

__device__ __forceinline__ unsigned xb_ld(unsigned* p)              { return __hip_atomic_load(p, __ATOMIC_RELAXED, __HIP_MEMORY_SCOPE_AGENT); }
__device__ __forceinline__ unsigned xb_add(unsigned* p, unsigned v) { return __hip_atomic_fetch_add(p, v, __ATOMIC_RELAXED, __HIP_MEMORY_SCOPE_AGENT); }
__device__ __forceinline__ unsigned xb_xcc_id() { return (unsigned)__builtin_amdgcn_s_getreg((3 << 11) | 20) & 0xFu; }
#define XB_SPIN(cond, bar) do { unsigned _sp = 0; while (cond) { __builtin_amdgcn_s_sleep(1); \
    if ((++_sp & 255u) == 0u) { if (xb_ld(&(bar)[XB_TMO])) break; if (_sp > XB_SPIN_CAP) { atomicAdd(&(bar)[XB_TMO], 1u); break; } } } } while (0)

struct XcdBarrier {
    unsigned* bar; unsigned x;
    volatile LAS unsigned* st;
};

__device__ __forceinline__ XcdBarrier xcd_barrier_post(unsigned* bar, volatile LAS unsigned* st) {
    XcdBarrier b; b.bar = bar; b.x = xb_xcc_id(); b.st = st;
    if (threadIdx.x == 0) (void)xb_add(&bar[XB_XCNT(b.x)], 1u);
    return b;
}
__device__ __forceinline__ void xcd_barrier_complete(unsigned* bar, unsigned x, unsigned& nloc, unsigned& nx) {
    const unsigned G = gridDim.x * gridDim.y * gridDim.z;
    unsigned sum, cnt, mine, sp = 0u;
    for (;;) {
        sum = 0u; cnt = 0u; mine = 0u;
#pragma unroll
        for (unsigned j = 0; j < 16; ++j) { const unsigned c = xb_ld(&bar[XB_XCNT(j)]); sum += c; cnt += (c > 0u) ? 1u : 0u; mine = (j == x) ? c : mine; }
        if (sum == G) break;
        __builtin_amdgcn_s_sleep(1);
        if ((++sp & 255u) == 0u) { if (xb_ld(&bar[XB_TMO])) break; if (sp > XB_SPIN_CAP) { atomicAdd(&bar[XB_TMO], 1u); break; } }
    }
    nloc = mine > 0u ? mine : 1u; nx = cnt > 0u ? cnt : 1u;
}

__device__ __forceinline__ void xcd_barrier(const XcdBarrier& b) {
    asm volatile("s_waitcnt vmcnt(0)" ::: "memory");
    __syncthreads();
    if (threadIdx.x == 0) {
        unsigned* bar = b.bar;
        __builtin_amdgcn_s_waitcnt(0);
        unsigned nloc = b.st[0], nx = b.st[1];
        if (nloc == 0u) { xcd_barrier_complete(bar, b.x, nloc, nx); b.st[0] = nloc; b.st[1] = nx; }
        const unsigned old = xb_add(&bar[XB_XSUB(b.x)], 1u);
        const unsigned gen = old / nloc;
        if (old + 1u == (gen + 1u) * nloc) {
            __builtin_amdgcn_fence(__ATOMIC_RELEASE, "agent");
            asm volatile("s_waitcnt vmcnt(0)" ::: "memory");
            const unsigned og = xb_add(&bar[XB_TOP], 1u);
            const unsigned tg = og / nx;
            if (og + 1u == (tg + 1u) * nx) xb_add(&bar[XB_TOPGEN], 1u);
            else XB_SPIN(xb_ld(&bar[XB_TOPGEN]) == tg, bar);
            __builtin_amdgcn_fence(__ATOMIC_ACQUIRE, "agent");
            xb_add(&bar[XB_XGEN(b.x)], 1u);
            asm volatile("s_waitcnt vmcnt(0)" ::: "memory");
        } else {
            XB_SPIN(xb_ld(&bar[XB_XGEN(b.x)]) == gen, bar);
            __builtin_amdgcn_fence(__ATOMIC_ACQUIRE, "agent");
            asm volatile("s_waitcnt vmcnt(0)" ::: "memory");
        }
    }
    __syncthreads();
}

__global__ void __launch_bounds__(512) mega(Params prm) {
    extern __shared__ __attribute__((aligned(16))) unsigned char lds_raw[];
    LAS unsigned char* lds = (LAS unsigned char*)lds_raw;
    Ctx C;
    C.x = prm.in[0]; C.norm_w = prm.in[1]; C.w_in = prm.in[2]; C.ln_w = prm.in[3]; C.ln_b = prm.in[4]; C.gws = prm.in[5]; C.gbs = prm.in[6]; C.conv_w = prm.in[7]; C.conv_b = prm.in[8];
    C.dt_bias = prm.in[9]; C.a_log = prm.in[10]; C.d_skip = prm.in[11]; C.ssm_nw = prm.in[12]; C.wa = prm.in[13]; C.wb = prm.in[14]; C.wc = prm.in[15]; C.wout = prm.in[16]; C.fnw = prm.in[17];
    C.out = prm.out; C.ws = prm.ws;
    unsigned char* ws = prm.ws;
    C.rowss = (u64*)(ws + WS_ROWSS); C.lnst = (u64*)(ws + WS_LNST); C.cosT = (float*)(ws + WS_COS); C.sinT = (float*)(ws + WS_SIN); C.dtb = (float*)(ws + WS_DTB); C.cum = (float*)(ws + WS_CUM);
    C.cdec = (float*)(ws + WS_CDEC); C.lse = (float*)(ws + WS_LSE); C.X32 = (float*)(ws + WS_X32); C.MG32 = (float*)(ws + WS_MG32);
    C.WIN = (bf16_t*)(ws + WS_WIN); C.WBR = (bf16_t*)(ws + WS_WBR); C.WOUT = (bf16_t*)(ws + WS_WOUT); C.XB = (bf16_t*)(ws + WS_XB); C.P = (bf16_t*)(ws + WS_P); C.XCV = (bf16_t*)(ws + WS_XCV);
    C.ST = (bf16_t*)(ws + WS_ST); C.OG = (bf16_t*)(ws + WS_OG); C.Y = (bf16_t*)(ws + WS_Y); C.MGB = (bf16_t*)(ws + WS_MGB); C.PREV = (bf16_t*)(ws + WS_PREV);
    const int G = gridDim.x, bid = blockIdx.x;
    volatile LAS unsigned* bst = (volatile LAS unsigned*)(lds + LDS_BYTES - 64);
    if (threadIdx.x == 0) { bst[0] = 0u; bst[1] = 0u; }
    __syncthreads();

    for (int ph = prm.ph_lo; ph < prm.ph_hi; ++ph) {
        if (ph == 0) {
#ifndef NO_P0
            phase_prologue(C, lds);
#ifdef PROBE_REP_P0
            __syncthreads(); phase_prologue(C, lds);
#endif
#endif
        } else if (ph == NPHASE - 1) {
            int tid = threadIdx.x; asm volatile("" : "+v"(tid));
            const int lane = tid & 63, gw = bid * 8 + (tid >> 6), NGW = G * 8;
            const u64* rss = C.rowss + 4 * MTOK;
            for (int m = gw; m < MTOK; m += NGW) {
                const float rs = rsqrtf(fx_get(rss + m, 1.f / RSS_SCALE) * (1.f / 2048.f) + 1e-6f);
                const f32x4* xr = (const f32x4*)(C.X32 + (size_t)m * DM) + lane; const f32x4* fw = (const f32x4*)C.fnw + lane; f32x4* o = (f32x4*)(C.out + (size_t)m * DM) + lane;
#pragma unroll
                for (int j = 0; j < 8; ++j) o[64 * j] = xr[64 * j] * rs * fw[64 * j];
            }
        } else {
            const int l = (ph - 1) / 5, sub = (ph - 1) % 5;
#ifdef PROBE_REP_SUB
            const int nrep = ((PROBE_REP_SUB >> sub) & 1) ? 2 : 1;
            for (int rep = 0; rep < nrep; ++rep) {
            if (rep) __syncthreads();
#endif
            if (sub == 0) {
                pg8::Gemm g{C.XB, C.WIN + (size_t)l * NP * DM, DM, DM}; pg8::Sched S; S.init(32, NP / 256, G, bid, 0, DM / 64);
                EpiProj E{C.P, C.rowss + l * MTOK, C.lnst + (size_t)l * MTOK * 2, C.dtb, C.dt_bias + l * 24, C.cosT, C.sinT};
#ifndef NO_G1
                pg8::gemm_phase<EpiProj>(lds, g, S, E);
#endif
            } else if (sub == 1) {
                for (int it = bid; it < 1792; it += G) {
                    if (it < 256) {
#ifndef NO_SSD1
                        ssd1_item(C, l, it, lds);
#endif
                    } else if (it < 1024) {
#ifndef NO_ATTN
                        attn_item(C, it - 256, lds);
#endif
                    } else {
#ifndef NO_GMLP
                        gmlp_item(C, l, it - 1024, lds);
#endif
                    }
                }
            } else if (sub == 2) {
                scan_states(C);
                for (int it = bid; it < 256; it += G) combine_item(C, it);
                { XcdBarrier xb; xb.bar = (unsigned*)(prm.ws + WS_BAR); xb.x = xb_xcc_id(); xb.st = bst; xcd_barrier(xb); }
                for (int it = bid; it < 256; it += G) {
#ifndef NO_SSD2
                    ssd2_item(C, l, it, lds);
#endif
                }
            } else if (sub == 3) {
                pg8::Gemm g{C.Y, C.WBR + (size_t)l * DM * KBR, KBR, KBR}; pg8::Sched S; S.init(32, 8, G, bid, 1, 0);
                EpiBranch E{C.P, C.MGB};
#ifndef NO_G2
                pg8::gemm_phase<EpiBranch>(lds, g, S, E);
#endif
            } else {
                pg8::Gemm g{C.MGB, C.WOUT + (size_t)l * DM * DM, DM, DM}; pg8::Sched S; S.init(32, 8, G, bid, 0, DM / 64);
                EpiOut E{C.x, C.X32, C.XB, C.rowss + (l + 1) * MTOK, l == 0 ? 0 : (l == NLAYER - 1 ? 2 : 1)};
#ifndef NO_G3
                pg8::gemm_phase<EpiOut>(lds, g, S, E);
#endif
            }
#ifdef PROBE_REP_SUB
            }
#endif
        }
        if (ph + 1 < prm.ph_hi) {
            if (ph == prm.ph_lo) {
                cg::this_grid().sync();
                (void)xcd_barrier_post((unsigned*)(prm.ws + WS_BAR), bst);
            } else {
                XcdBarrier xb; xb.bar = (unsigned*)(prm.ws + WS_BAR); xb.x = xb_xcc_id(); xb.st = bst;
                xcd_barrier(xb);
            }
        }
    }
}

extern "C" void kernel_launch(void* const* d_in, const int* in_sizes, int n_in, void* d_out, int out_size, void* d_ws, size_t ws_size, hipStream_t stream) {
    static int grid = 0;
    if (grid == 0) {
        if (n_in != 18 || ws_size < WS_END) { fprintf(stderr, "kernel_launch: unexpected inputs (n_in %d, ws %zu < %zu)\n", n_in, ws_size, (size_t)WS_END); grid = -1; return; }
        int dev = 0, cus = 0, per_cu = 0;
        hipGetDevice(&dev); hipDeviceGetAttribute(&cus, hipDeviceAttributeMultiprocessorCount, dev);
        hipFuncSetAttribute((const void*)mega, hipFuncAttributeMaxDynamicSharedMemorySize, LDS_BYTES);
        if (hipOccupancyMaxActiveBlocksPerMultiprocessor(&per_cu, (const void*)mega, 512, LDS_BYTES) != hipSuccess || per_cu < 1) per_cu = 1;
        (void)hipGetLastError();
        grid = cus * per_cu;
        if (grid <= 0) grid = 256;
    }
    if (grid < 0) return;
    Params p{};
    for (int i = 0; i < 18; ++i) p.in[i] = (const float*)d_in[i];
    p.out = (float*)d_out; p.ws = (unsigned char*)d_ws;
#if N_LAUNCH_MODE == 1
    p.ph_lo = 0; p.ph_hi = NPHASE;
    void* args[] = {&p};
    hipError_t e = hipLaunchCooperativeKernel((const void*)mega, dim3(grid), dim3(512), args, LDS_BYTES, stream);
    if (e != hipSuccess) fprintf(stderr, "cooperative launch failed: %s (grid %d)\n", hipGetErrorString(e), grid);
#else
#ifdef DBG_LAST
    for (int ph = 0; ph <= DBG_LAST; ++ph) { p.ph_lo = ph; p.ph_hi = ph + 1; hipLaunchKernelGGL(mega, dim3(grid), dim3(512), LDS_BYTES, stream, p); }
    { Ctx C{}; unsigned char* ws = (unsigned char*)d_ws; C.out = (float*)d_out; C.dtb = (float*)(ws + WS_DTB); C.cum = (float*)(ws + WS_CUM); C.cdec = (float*)(ws + WS_CDEC); C.lse = (float*)(ws + WS_LSE); C.X32 = (float*)(ws + WS_X32);
      C.XB = (bf16_t*)(ws + WS_XB); C.P = (bf16_t*)(ws + WS_P); C.XCV = (bf16_t*)(ws + WS_XCV); C.ST = (bf16_t*)(ws + WS_ST); C.OG = (bf16_t*)(ws + WS_OG); C.Y = (bf16_t*)(ws + WS_Y); C.MGB = (bf16_t*)(ws + WS_MGB);
      hipLaunchKernelGGL(dbg_dump, dim3(1024), dim3(512), 0, stream, C); }
#else
    for (int ph = 0; ph < NPHASE; ++ph) { p.ph_lo = ph; p.ph_hi = ph + 1; hipLaunchKernelGGL(mega, dim3(grid), dim3(512), LDS_BYTES, stream, p); }
#endif
#endif
}
```

```cpp
#include <hip/hip_runtime.h>
#include <hip/hip_cooperative_groups.h>
#include <cstdio>
namespace cg = cooperative_groups;

#define LAS __attribute__((address_space(3)))
typedef unsigned short bf16_t;
typedef short bf16x8 __attribute__((ext_vector_type(8)));
typedef float f32x4 __attribute__((ext_vector_type(4)));
typedef unsigned u32x4 __attribute__((ext_vector_type(4)));
typedef unsigned u32x2 __attribute__((ext_vector_type(2)));

#ifndef N_LAUNCH_MODE
#define N_LAUNCH_MODE 1
#endif

constexpr int SEQ = 2048, MTOK = 8192, DM = 2048, NLAYER = 4;
constexpr int NIN = 19992, NP = 20224;
constexpr int C_U = 0, C_V = 1536, C_ZA = 3072, C_Q = 4608, C_K = 6144, C_VV = 7680, C_ZB = 9216, C_ZC = 9728, C_XBC = 11264, C_DT = 13824, C_GR = 14080;
constexpr int KBR = 3584;
constexpr int NPHASE = 2 + 5 * NLAYER;
constexpr int LDS_BYTES = 147456;

constexpr size_t al256(size_t x) { return (x + 255) & ~(size_t)255; }
constexpr size_t WS_ROWSS = 0;
constexpr size_t WS_LNST  = al256(WS_ROWSS + 5 * (size_t)MTOK * 8);
constexpr size_t WS_COS   = al256(WS_LNST + 4 * (size_t)MTOK * 2 * 8);
constexpr size_t WS_SIN   = al256(WS_COS + (size_t)SEQ * 64 * 4);
constexpr size_t WS_DTB   = al256(WS_SIN + (size_t)SEQ * 64 * 4);
constexpr size_t WS_CUM   = al256(WS_DTB + (size_t)MTOK * 24 * 4);
constexpr size_t WS_CDEC  = al256(WS_CUM + (size_t)MTOK * 24 * 4);
constexpr size_t WS_LSE   = al256(WS_CDEC + 4 * 16 * 24 * 4);
constexpr size_t WS_WIN   = al256(WS_LSE + 3 * (size_t)MTOK * 4 * 4);
constexpr size_t WS_WBR   = al256(WS_WIN + (size_t)NLAYER * NP * DM * 2);
constexpr size_t WS_WOUT  = al256(WS_WBR + (size_t)NLAYER * DM * KBR * 2);
constexpr size_t WS_XB    = al256(WS_WOUT + (size_t)NLAYER * DM * DM * 2);
constexpr size_t WS_X32   = al256(WS_XB + (size_t)MTOK * DM * 2);
constexpr size_t WS_P     = al256(WS_X32 + (size_t)MTOK * DM * 4);
constexpr size_t WS_XCV   = al256(WS_P + (size_t)MTOK * NP * 2);
constexpr size_t WS_ST    = al256(WS_XCV + (size_t)MTOK * 2560 * 2);
constexpr size_t WS_OG    = al256(WS_ST + (size_t)4 * 16 * 24 * 64 * 128 * 2);
constexpr size_t WS_Y     = al256(WS_OG + 3 * (size_t)MTOK * 512 * 2);
constexpr size_t WS_MG32  = al256(WS_Y + (size_t)MTOK * KBR * 2);
constexpr size_t WS_MGB   = al256(WS_MG32 + (size_t)MTOK * DM * 4);
constexpr size_t WS_TBL   = al256(WS_MGB + (size_t)MTOK * DM * 2);
constexpr size_t WS_BAR   = WS_TBL + 256;
constexpr size_t WS_PREV  = WS_BAR + 16384;
constexpr size_t WS_GT    = al256(WS_PREV + (size_t)4 * 16 * 24 * 64 * 128 * 2);
constexpr size_t WS_END   = al256(WS_GT + (size_t)3 * MTOK * DM * 2);

__device__ __forceinline__ float bf_lo(unsigned u) { return __uint_as_float(u << 16); }
__device__ __forceinline__ float bf_hi(unsigned u) { return __uint_as_float(u & 0xffff0000u); }
typedef __bf16 bf16v2_t __attribute__((ext_vector_type(2)));
typedef float f32v2_t __attribute__((ext_vector_type(2)));
__device__ __forceinline__ unsigned pk_bf16(float lo, float hi) { f32v2_t v = {lo, hi}; bf16v2_t r = __builtin_convertvector(v, bf16v2_t); return __builtin_bit_cast(unsigned, r); }
__device__ __forceinline__ float fexp(float x) { return __builtin_amdgcn_exp2f(x * 1.44269504089f); }
__device__ __forceinline__ float frcp(float x) { return __builtin_amdgcn_rcpf(x); }
__device__ __forceinline__ float sigm(float x) { return frcp(1.f + fexp(-x)); }
__device__ __forceinline__ float silu_(float x) { return x * sigm(x); }
__device__ __forceinline__ float gelu_(float x) { return x * sigm(1.5957691216f * (x + 0.044715f * x * x * x)); }
__device__ __forceinline__ void unpack8(const u32x4 v, float (&f)[8]) { f[0] = bf_lo(v.x); f[1] = bf_hi(v.x); f[2] = bf_lo(v.y); f[3] = bf_hi(v.y); f[4] = bf_lo(v.z); f[5] = bf_hi(v.z); f[6] = bf_lo(v.w); f[7] = bf_hi(v.w); }
__device__ __forceinline__ u32x4 pack8(const float (&f)[8]) { u32x4 o; o.x = pk_bf16(f[0], f[1]); o.y = pk_bf16(f[2], f[3]); o.z = pk_bf16(f[4], f[5]); o.w = pk_bf16(f[6], f[7]); return o; }
__device__ __forceinline__ bf16x8 frag2(u32x2 a, u32x2 b) { u32x4 t; t.x = a.x; t.y = a.y; t.z = b.x; t.w = b.y; return __builtin_bit_cast(bf16x8, t); }
__device__ __forceinline__ bf16x8 ldsfrag(const LAS unsigned char* p) { return *(const LAS bf16x8*)p; }
typedef unsigned long long u64;
constexpr float RSS_SCALE = 65536.f, LNS_SCALE = 1048576.f;
__device__ __forceinline__ void fx_add(u64* p, float v, float scale) { __hip_atomic_fetch_add(p, (u64)(long long)__float2ll_rn(v * scale), __ATOMIC_RELAXED, __HIP_MEMORY_SCOPE_AGENT); }
__device__ __forceinline__ float fx_get(const u64* p, float inv_scale) { return (float)(long long)(*p) * inv_scale; }
__device__ __forceinline__ int swz(int row, int col) { return (((col >> 3) ^ ((row >> 3) & 15)) << 3) | (col & 7); }
#define MFMA16(a, b, c) __builtin_amdgcn_mfma_f32_16x16x32_bf16((a), (b), (c), 0, 0, 0)
#define LDS_WAIT() asm volatile("s_waitcnt lgkmcnt(0)" ::: "memory")

namespace pg8 {
constexpr int BM = 256, BK = 64, HALF = 128, HTB = HALF * BK * 2, NXCD = 8, WGM = 4;
__device__ __forceinline__ int lds_byte(int r, int c) { const int st = (r >> 4) * 2 + (c >> 5), rr = r & 15, cc = c & 31, ob = rr * 64 + cc * 2; return st * 1024 + (ob ^ (((ob >> 9) & 1) << 5)); }
__device__ __forceinline__ void stage_rc(int b, int& R, int& C) { const int st = b / 1024, sb = b % 1024, swz = sb ^ (((sb >> 9) & 1) << 5); R = (st >> 1) * 16 + swz / 64; C = (st & 1) * 32 + (swz % 64) / 2; }
__device__ __forceinline__ int perm32(int rho) { const int n = rho >> 4, i = rho & 15; return 8 * (i >> 2) + 4 * n + (i & 3); }

struct Unit { int pm, pn, k0, nt, br; };
struct Gemm { const bf16_t* A; const bf16_t* Bt; int lda, ldb; };
struct Sched {
    int nM, nN, nwg, G, c, mode, nt0;
    __device__ void init(int nM_, int nN_, int G_, int c_, int mode_, int nt_) { nM = nM_; nN = nN_; nwg = nM * nN; G = G_; c = c_; mode = mode_; nt0 = nt_; }
    __device__ bool tile(int round, int& pm, int& pn) const {
        const long L = (long)round * G + c; if (L >= nwg) return false;
        int wgid = (int)L; { const int q = nwg / NXCD, r = nwg % NXCD, xcd = wgid % NXCD, off = wgid / NXCD; wgid = (xcd < r ? xcd * (q + 1) : r * (q + 1) + (xcd - r) * q) + off; }
        const int nig = WGM * nN, gid = wgid / nig, fm = gid * WGM, gsz = (nM - fm) < WGM ? (nM - fm) : WGM;
        pm = fm + ((wgid % nig) % gsz); pn = (wgid % nig) / gsz; return true;
    }
    __device__ bool next(int i, Unit& u) const {
        if (mode == 0) { u.k0 = 0; u.nt = nt0; u.br = 0; return tile(i, u.pm, u.pn); }
        const int rd = i / 3, br = i - 3 * rd; u.br = br; u.k0 = br == 0 ? 0 : (br == 1 ? 1536 : 2048); u.nt = br == 1 ? 8 : 24; return tile(rd, u.pm, u.pn);
    }
};

template <class Epi>
__device__ __forceinline__ void gemm_phase(LAS unsigned char* lds, const Gemm g, const Sched& S, const Epi& E) {
    int tid = threadIdx.x; asm volatile("" : "+v"(tid));
    const int wid = __builtin_amdgcn_readfirstlane(tid >> 6), lane = tid & 63, wr = wid >> 2, wc = wid & 3, fr = lane & 15, fq = lane >> 4;
    unsigned voffA[2], voffB[2];
#pragma unroll
    for (int i = 0; i < 2; ++i) { int R, C; stage_rc(tid * 16 + i * 8192, R, C); const int Rb = (R & ~31) + perm32(R & 31);
        voffA[i] = (unsigned)(R * g.lda + C) * 2u; voffB[i] = (unsigned)(Rb * g.ldb + C) * 2u; }
    const size_t kstep = (size_t)(BK * 2);
    const size_t hstepA = (size_t)HALF * g.lda * 2, hstepB = (size_t)HALF * g.ldb * 2;
    const unsigned ldsw = (unsigned)wid * 1024u;
    const int aoff = lds_byte(wr * 64 + fr, fq * 8), boff = lds_byte(wc * 32 + fr, fq * 8);
#define PG8_SA(b, h) (((b) * 2 + (h)) * HTB)
#define PG8_SB(b, h) ((4 + (b) * 2 + (h)) * HTB)
#define PG8_STAGE(bufoff, gbase, voff) do { _Pragma("unroll") for (int _i = 0; _i < 2; ++_i) \
        __builtin_amdgcn_global_load_lds((const unsigned*)((const char*)(gbase) + (voff)[_i]), (LAS unsigned*)(lds + (bufoff) + ldsw + _i * 8192), 16, 0, 0); } while (0)
#define PG8_LDA(dst, b, h) do { _Pragma("unroll") for (int m = 0; m < 4; ++m) _Pragma("unroll") for (int k = 0; k < 2; ++k) dst[m][k] = *(const LAS bf16x8*)(lds + PG8_SA(b, h) + aoff + m * 2048 + k * 1024); } while (0)
#define PG8_LDB(dst, b, h) do { _Pragma("unroll") for (int n = 0; n < 2; ++n) _Pragma("unroll") for (int k = 0; k < 2; ++k) dst[n][k] = *(const LAS bf16x8*)(lds + PG8_SB(b, h) + boff + n * 2048 + k * 1024); } while (0)
#define PG8_MMA(ai, bj, At, Bt) do { __builtin_amdgcn_s_setprio(1); _Pragma("unroll") for (int m = 0; m < 4; ++m) _Pragma("unroll") for (int n = 0; n < 2; ++n) _Pragma("unroll") for (int k = 0; k < 2; ++k) \
        acc[ai][bj][m][n] = __builtin_amdgcn_mfma_f32_16x16x32_bf16(Bt[n][k], At[m][k], acc[ai][bj][m][n], 0, 0, 0); __builtin_amdgcn_s_setprio(0); } while (0)
#define PG8_WAIT_V(n) asm volatile("s_waitcnt vmcnt(" #n ")" ::: "memory")
#define PG8_WAIT_L(n) asm volatile("s_waitcnt lgkmcnt(" #n ")" ::: "memory")
#define PG8_BAR __builtin_amdgcn_s_barrier()
#define PG8_SCHED __builtin_amdgcn_sched_barrier(0)
    Unit cur, nxt; int ui = 0;
    if (!S.next(0, cur)) return;
    f32x4 acc[2][2][4][2];
#pragma unroll
    for (int a = 0; a < 2; ++a)
#pragma unroll
        for (int b = 0; b < 2; ++b)
#pragma unroll
            for (int m = 0; m < 4; ++m)
#pragma unroll
                for (int n = 0; n < 2; ++n) acc[a][b][m][n] = (f32x4){0.f, 0.f, 0.f, 0.f};
    bf16x8 At[4][2], B0[2][2], B1[2][2];
    const char* cA = (const char*)g.A + (size_t)cur.pm * 2 * hstepA + (size_t)cur.k0 * 2;
    const char* cB = (const char*)g.Bt + (size_t)cur.pn * 2 * hstepB + (size_t)cur.k0 * 2;
    asm volatile("" : "+s"(cA), "+s"(cB), "+v"(voffA[0]), "+v"(voffA[1]), "+v"(voffB[0]), "+v"(voffB[1]));
    PG8_STAGE(PG8_SB(0, 0), cB, voffB); PG8_STAGE(PG8_SB(0, 1), cB + hstepB, voffB); PG8_STAGE(PG8_SA(0, 0), cA, voffA); PG8_STAGE(PG8_SA(0, 1), cA + hstepA, voffA);
    if (wr == 1) PG8_BAR;
    PG8_WAIT_V(2); PG8_BAR;
    PG8_STAGE(PG8_SB(1, 0), cB + kstep, voffB); PG8_STAGE(PG8_SA(1, 0), cA + kstep, voffA); PG8_STAGE(PG8_SB(1, 1), cB + hstepB + kstep, voffB);
    PG8_WAIT_V(6); PG8_BAR;
    for (;;) {
        const bool has_next = S.next(ui + 1, nxt);
        const char* nA = has_next ? (const char*)g.A + (size_t)nxt.pm * 2 * hstepA + (size_t)nxt.k0 * 2 : cA;
        const char* nB = has_next ? (const char*)g.Bt + (size_t)nxt.pn * 2 * hstepB + (size_t)nxt.k0 * 2 : cB;
        const int nt = cur.nt;
        for (int t = 0; t < nt; t += 2) {
            const bool last = (t == nt - 2);
            const char* a1 = cA + (size_t)(t + 1) * kstep;
            const char* a2 = last ? nA : cA + (size_t)(t + 2) * kstep; const char* b2 = last ? nB : cB + (size_t)(t + 2) * kstep;
            const char* a3 = a2 + kstep; const char* b3 = b2 + kstep;
            PG8_LDB(B0, 0, 0); PG8_LDB(B1, 0, 1); PG8_SCHED; PG8_LDA(At, 0, 0); PG8_STAGE(PG8_SA(1, 1), a1 + hstepA, voffA);
            PG8_WAIT_V(8); PG8_WAIT_L(0); PG8_BAR; PG8_MMA(0, 0, At, B0); PG8_MMA(0, 1, At, B1); PG8_BAR; PG8_SCHED;
            PG8_LDA(At, 0, 1); PG8_STAGE(PG8_SB(0, 0), b2, voffB); PG8_STAGE(PG8_SB(0, 1), b2 + hstepB, voffB); PG8_STAGE(PG8_SA(0, 0), a2, voffA);
            PG8_WAIT_V(8); PG8_WAIT_L(0); PG8_BAR; PG8_MMA(1, 0, At, B0); PG8_MMA(1, 1, At, B1); PG8_BAR; PG8_SCHED;
            PG8_LDB(B0, 1, 0); PG8_LDB(B1, 1, 1); PG8_SCHED; PG8_LDA(At, 1, 0); PG8_STAGE(PG8_SA(0, 1), a2 + hstepA, voffA);
            PG8_WAIT_V(8); PG8_WAIT_L(0); PG8_BAR; PG8_MMA(0, 0, At, B0); PG8_MMA(0, 1, At, B1); PG8_BAR; PG8_SCHED;
            PG8_LDA(At, 1, 1); PG8_STAGE(PG8_SB(1, 0), b3, voffB); PG8_STAGE(PG8_SB(1, 1), b3 + hstepB, voffB); PG8_STAGE(PG8_SA(1, 0), a3, voffA);
            PG8_WAIT_V(8); PG8_WAIT_L(0); PG8_BAR; PG8_MMA(1, 0, At, B0); PG8_MMA(1, 1, At, B1); PG8_BAR; PG8_SCHED;
        }
        if (wr == 0) PG8_BAR;
        E(acc, cur, wr, wc, fr, fq);
        if (!has_next) break;
        if (!E.keep(cur))
#pragma unroll
        for (int a = 0; a < 2; ++a)
#pragma unroll
            for (int b = 0; b < 2; ++b)
#pragma unroll
                for (int m = 0; m < 4; ++m)
#pragma unroll
                    for (int n = 0; n < 2; ++n) acc[a][b][m][n] = (f32x4){0.f, 0.f, 0.f, 0.f};
        cur = nxt; cA = nA; cB = nB; ++ui;
        if (wr == 1) PG8_BAR;
    }
    PG8_WAIT_V(0);
    PG8_BAR;
#undef PG8_SA
#undef PG8_SB
#undef PG8_STAGE
#undef PG8_LDA
#undef PG8_LDB
#undef PG8_MMA
#undef PG8_WAIT_V
#undef PG8_WAIT_L
#undef PG8_BAR
#undef PG8_SCHED
}
}

struct EpiProj {
    bf16_t* P; const u64* rowss; u64* lnst; float* dtb; const float* dt_bias; const float* cosT; const float* sinT; bf16_t* GT;
    __device__ __forceinline__ bool keep(const pg8::Unit&) const { return false; }
    template <int KIND>
    __device__ __forceinline__ void body(f32x4 (&acc)[2][2][4][2], const pg8::Unit& u, int wr, int wc, int fr, int fq) const {
        const int row0 = u.pm * 256 + wr * 64 + fr, colt = u.pn * 256 + wc * 32 + 8 * fq;
        float rsv[8];
#pragma unroll
        for (int q = 0; q < 8; ++q) rsv[q] = fx_get(rowss + row0 + (q >> 2) * 128 + (q & 3) * 16, 1.f / RSS_SCALE);
        f32x4 csn = {0.f, 0.f, 0.f, 0.f}, snn = {0.f, 0.f, 0.f, 0.f};
        if (KIND == 4) { const int pos = row0 & (SEQ - 1), i0 = 16 * wc + 4 * fq; csn = *(const f32x4*)(cosT + pos * 64 + i0); snn = *(const f32x4*)(sinT + pos * 64 + i0); }
#pragma unroll
        for (int q = 0; q < 8; ++q) {
                const int ai = q >> 2, m = q & 3;
                const int row = row0 + ai * 128 + m * 16;
                const float rs = rsqrtf(rsv[q] * (1.f / 2048.f) + 1e-6f);
                float s1 = 0.f, s2 = 0.f;
                const f32x4 cs = csn, sn = snn;
                if (KIND == 4 && q < 7) { const int pos = (row0 + ((q + 1) >> 2) * 128 + ((q + 1) & 3) * 16) & (SEQ - 1), i0 = 16 * wc + 4 * fq; csn = *(const f32x4*)(cosT + pos * 64 + i0); snn = *(const f32x4*)(sinT + pos * 64 + i0); }
#pragma unroll
                for (int bj = 0; bj < 2; ++bj) {
                    const f32x4 a0 = acc[ai][bj][m][0] * rs, a1 = acc[ai][bj][m][1] * rs;
                    float v[8] = {a0[0], a0[1], a0[2], a0[3], a1[0], a1[1], a1[2], a1[3]};
                    if (KIND == 1 || KIND == 2) {
#pragma unroll
                        for (int j = 0; j < 8; ++j) { v[j] = gelu_(v[j]); if (KIND == 2) { s1 += v[j]; s2 += v[j] * v[j]; } }
                    }
                    if (KIND == 3) {
#pragma unroll
                        for (int j = 0; j < 8; ++j) v[j] = silu_(v[j]);
                    }
                    if (KIND == 5) {
#pragma unroll
                        for (int j = 0; j < 8; ++j) v[j] = sigm(v[j]);
                    }
                    if (KIND == 4) {
                        const float sc = (u.pn < 24) ? 0.08838834764831845f : 1.f;
#pragma unroll
                        for (int i = 0; i < 4; ++i) { const float a = v[2 * i], b = v[2 * i + 1]; v[2 * i] = (a * cs[i] - b * sn[i]) * sc; v[2 * i + 1] = (b * cs[i] + a * sn[i]) * sc; }
                    }
                    if (KIND == 6) {
                        if (wc == 0 && bj == 0 && fq < 3) {
                            int fqx = fq; asm volatile("" : "+v"(fqx));
                            float o[8];
#pragma unroll
                            for (int j = 0; j < 8; ++j) { const float x = v[j] + dt_bias[8 * fqx + j]; const float e = fexp(-fabsf(x)); o[j] = fmaxf(x, 0.f) + (e < 1e-3f ? e * (1.f - e * (0.5f - e * (1.f / 3.f))) : __logf(1.f + e)); }
                            float* d = dtb + (size_t)row * 24 + 8 * fqx;
                            *(f32x4*)d = (f32x4){o[0], o[1], o[2], o[3]}; *(f32x4*)(d + 4) = (f32x4){o[4], o[5], o[6], o[7]};
                        }
                    } else {
                        if (KIND == 5) { const int gi = u.pn - 55, gbr = gi >> 3, gpn = gi & 7; int lnx = fq * 16 + fr; asm volatile("" : "+v"(lnx));
                            *(u32x4*)(GT + (((((size_t)(gbr * 256 + u.pm * 8 + gpn) * 8 + (wr * 4 + wc)) * 16 + (q * 2 + bj)) * 64 + lnx) * 8)) = pack8(v); }
                        else *(u32x4*)(P + (size_t)row * NP + colt + bj * 128) = pack8(v);
                    }
                }
                if (KIND == 2) {
                    s1 += __shfl_xor(s1, 16); s1 += __shfl_xor(s1, 32); s2 += __shfl_xor(s2, 16); s2 += __shfl_xor(s2, 32);
                    if (fq == 0) { fx_add(lnst + 2 * row, s1, LNS_SCALE); fx_add(lnst + 2 * row + 1, s2, LNS_SCALE); }
                }
                asm volatile("" ::: "memory");
        }
    }
    __device__ __forceinline__ void operator()(f32x4 (&acc)[2][2][4][2], const pg8::Unit& u, int wr, int wc, int fr, int fq) const {
        const int pn = u.pn;
        if (pn < 6) body<1>(acc, u, wr, wc, fr, fq);
        else if (pn < 12) body<2>(acc, u, wr, wc, fr, fq);
        else if (pn < 18) body<3>(acc, u, wr, wc, fr, fq);
        else if (pn < 30) body<4>(acc, u, wr, wc, fr, fq);
        else if (pn < 36) body<0>(acc, u, wr, wc, fr, fq);
        else if (pn < 44) body<3>(acc, u, wr, wc, fr, fq);
        else if (pn < 54) body<0>(acc, u, wr, wc, fr, fq);
        else if (pn == 54) body<6>(acc, u, wr, wc, fr, fq);
        else body<5>(acc, u, wr, wc, fr, fq);
    }
};
struct EpiBranch {
    const bf16_t* GT; bf16_t* MGB;
    __device__ __forceinline__ bool keep(const pg8::Unit& u) const { return u.br < 2; }
    __device__ __forceinline__ void operator()(f32x4 (&acc)[2][2][4][2], const pg8::Unit& u, int wr, int wc, int fr, int fq) const {
        const int row0 = u.pm * 256 + wr * 64 + fr, colt = u.pn * 256 + wc * 32 + 8 * fq, br = u.br;
        const size_t gcur = ((size_t)(br * 256 + u.pm * 8 + u.pn) * 8 + (wr * 4 + wc)) * 16, gnxt = ((size_t)((br < 2 ? br + 1 : br) * 256 + u.pm * 8 + u.pn) * 8 + (wr * 4 + wc)) * 16;
        int ln = fq * 16 + fr; asm volatile("" : "+v"(ln));
#pragma unroll
        for (int qq = 0; qq < 8; qq += 2) {
            u32x4 gc4[2][2], gn4[2][2];
#pragma unroll
            for (int d = 0; d < 2; ++d) { const int q = qq + d;
                gc4[d][0] = *(const u32x4*)(GT + ((gcur + q * 2) * 64 + ln) * 8); gc4[d][1] = *(const u32x4*)(GT + ((gcur + q * 2 + 1) * 64 + ln) * 8); gn4[d][0] = *(const u32x4*)(GT + ((gnxt + q * 2) * 64 + ln) * 8); gn4[d][1] = *(const u32x4*)(GT + ((gnxt + q * 2 + 1) * 64 + ln) * 8); }
#pragma unroll
            for (int d = 0; d < 2; ++d) {
                const int q = qq + d, ai = q >> 2, m = q & 3;
#pragma unroll
                for (int bj = 0; bj < 2; ++bj) {
                    float gc[8], gn[8]; unpack8(gc4[d][bj], gc); unpack8(gn4[d][bj], gn);
                    float f[8];
#pragma unroll
                    for (int j = 0; j < 8; ++j) {
                        if (br == 0) f[j] = gc[j] * frcp(fmaxf(gn[j], 1e-20f));
                        else if (br == 1) f[j] = fmaxf(gc[j], 1e-20f) * frcp(fmaxf(gn[j], 1e-20f));
                        else f[j] = fmaxf(gc[j], 1e-20f);
                    }
                    f32x4& a0 = acc[ai][bj][m][0]; f32x4& a1 = acc[ai][bj][m][1];
                    a0 = a0 * (f32x4){f[0], f[1], f[2], f[3]}; a1 = a1 * (f32x4){f[4], f[5], f[6], f[7]};
                    if (br == 2) { const float v[8] = {a0[0], a0[1], a0[2], a0[3], a1[0], a1[1], a1[2], a1[3]}; *(u32x4*)(MGB + (size_t)(row0 + ai * 128 + m * 16) * DM + colt + bj * 128) = pack8(v); }
                }
            }
            asm volatile("" ::: "memory");
        }
    }
};
struct EpiOut {
    const float* xin; float* X32; bf16_t* XB; u64* rowss_next; int mode;
    __device__ __forceinline__ bool keep(const pg8::Unit&) const { return false; }
    __device__ __forceinline__ void operator()(f32x4 (&acc)[2][2][4][2], const pg8::Unit& u, int wr, int wc, int fr, int fq) const {
        const int row0 = u.pm * 256 + wr * 64 + fr, colt = u.pn * 256 + wc * 32 + 8 * fq;
        f32x4 nx[4], cx[4];
#define LDX(dst, q_) do { const size_t o_ = (size_t)(row0 + ((q_) >> 2) * 128 + ((q_) & 3) * 16) * DM + colt; \
        if (mode == 0) { const float* xp = xin + o_; dst[0] = *(const f32x4*)xp; dst[1] = *(const f32x4*)(xp + 4); dst[2] = *(const f32x4*)(xp + 128); dst[3] = *(const f32x4*)(xp + 132); } \
        else { const u32x4 a_ = *(const u32x4*)(XB + o_), b_ = *(const u32x4*)(XB + o_ + 128); \
               dst[0] = (f32x4){bf_lo(a_.x), bf_hi(a_.x), bf_lo(a_.y), bf_hi(a_.y)}; dst[1] = (f32x4){bf_lo(a_.z), bf_hi(a_.z), bf_lo(a_.w), bf_hi(a_.w)}; \
               dst[2] = (f32x4){bf_lo(b_.x), bf_hi(b_.x), bf_lo(b_.y), bf_hi(b_.y)}; dst[3] = (f32x4){bf_lo(b_.z), bf_hi(b_.z), bf_lo(b_.w), bf_hi(b_.w)}; } } while (0)
        LDX(nx, 0);
#pragma unroll
        for (int q = 0; q < 8; ++q) {
            const int ai = q >> 2, m = q & 3;
            const int row = row0 + ai * 128 + m * 16; float ss = 0.f;
            cx[0] = nx[0]; cx[1] = nx[1]; cx[2] = nx[2]; cx[3] = nx[3];
            if (q < 7) LDX(nx, q + 1);
#pragma unroll
            for (int bj = 0; bj < 2; ++bj) {
                const size_t off = (size_t)row * DM + colt + bj * 128;
                const f32x4 x0 = cx[2 * bj] + acc[ai][bj][m][0], x1 = cx[2 * bj + 1] + acc[ai][bj][m][1];
                if (mode == 2) { *(f32x4*)(X32 + off) = x0; *(f32x4*)(X32 + off + 4) = x1; }
                else { u32x4 w; w.x = pk_bf16(x0[0], x0[1]); w.y = pk_bf16(x0[2], x0[3]); w.z = pk_bf16(x1[0], x1[1]); w.w = pk_bf16(x1[2], x1[3]); *(u32x4*)(XB + off) = w; }
                ss += (x0[0] * x0[0] + x0[1] * x0[1]) + (x0[2] * x0[2] + x0[3] * x0[3]) + (x1[0] * x1[0] + x1[1] * x1[1]) + (x1[2] * x1[2] + x1[3] * x1[3]);
            }
            ss += __shfl_xor(ss, 16); ss += __shfl_xor(ss, 32);
            if (fq == 0) fx_add(rowss_next + row, ss, RSS_SCALE);
            asm volatile("" ::: "memory");
        }
#undef LDX
    }
};

struct Params { const float* in[18]; float* out; unsigned char* ws; int ph_lo, ph_hi; };
struct Ctx {
    const float *x, *norm_w, *w_in, *ln_w, *ln_b, *gws, *gbs, *conv_w, *conv_b, *dt_bias, *a_log, *d_skip, *ssm_nw, *wa, *wb, *wc, *wout, *fnw;
    float* out; unsigned char* ws;
    u64 *rowss, *lnst; float *cosT, *sinT, *dtb, *cum, *cdec, *lse, *X32, *MG32;
    bf16_t *WIN, *WBR, *WOUT, *XB, *P, *XCV, *ST, *OG, *Y, *MGB, *PREV;
};

__device__ __forceinline__ int win_dst_row(int sc) {
    if (sc >= NIN) return -1;
    if (sc >= C_Q && sc < C_VV) { const int off = sc - C_Q, hd = off >> 7, i = off & 127; return C_Q + hd * 128 + (i < 64 ? 2 * i : 2 * (i - 64) + 1); }
    if (sc < 13848) return sc;
    return sc + 232;
}
template <bool WIN>
__device__ __forceinline__ void transpose_item(const float* W, int Nsrc, bf16_t* WT, int ldt, int koff, const float* kscale, LAS float* scr, int kb, int nb, int lane) {
    const int k0 = 64 * kb, n0 = 32 * nb;
    const int ks = lane >> 3, c4 = lane & 7;
    const bool cok = (n0 + 4 * c4 + 3) < Nsrc;
    f32x4 v[8];
#pragma unroll
    for (int i = 0; i < 8; ++i) v[i] = cok ? *(const f32x4*)(W + (size_t)(k0 + 8 * i + ks) * Nsrc + n0 + 4 * c4) : (f32x4){0.f, 0.f, 0.f, 0.f};
#pragma unroll
    for (int i = 0; i < 8; ++i) { const int kk = 8 * i + ks; f32x4 x = v[i]; if (WIN) x = x * kscale[k0 + kk]; LAS float* d = scr + kk * 33 + 4 * c4; d[0] = x[0]; d[1] = x[1]; d[2] = x[2]; d[3] = x[3]; }
    LDS_WAIT();
    const int c = lane & 7;
#pragma unroll
    for (int j = 0; j < 4; ++j) { const int n = (lane >> 3) + 8 * j; const LAS float* p = scr + (8 * c) * 33 + n;
        u32x4 o; o.x = pk_bf16(p[0 * 33], p[1 * 33]); o.y = pk_bf16(p[2 * 33], p[3 * 33]); o.z = pk_bf16(p[4 * 33], p[5 * 33]); o.w = pk_bf16(p[6 * 33], p[7 * 33]);
        const int dr = WIN ? win_dst_row(n0 + n) : n0 + n;
        if (dr >= 0) *(u32x4*)(WT + (size_t)dr * ldt + koff + k0 + 8 * c) = o; }
    LDS_WAIT();
}
__device__ __forceinline__ void phase_prologue(const Ctx& C, LAS unsigned char* lds) {
    int tid = threadIdx.x; asm volatile("" : "+v"(tid));
    const int lane = tid & 63, wave = tid >> 6;
    const int gw = blockIdx.x * 8 + wave, NGW = gridDim.x * 8;
    const int gt = blockIdx.x * 512 + tid, NGT = gridDim.x * 512;
    if (blockIdx.x == 0) for (int i = tid; i < 4096; i += 512) ((unsigned*)(C.ws + WS_BAR))[i] = 0u;
    for (int i = gt; i < 4 * MTOK; i += NGT) C.rowss[MTOK + i] = 0ull;
    for (int i = gt; i < 8 * MTOK; i += NGT) C.lnst[i] = 0ull;
    for (int i = gt; i < SEQ * 64; i += NGT) { const int pos = i >> 6, k = i & 63; const float inv = 1.0f / powf(10000.0f, (float)(2 * k) / 128.0f); const float ang = (float)pos * inv; C.cosT[i] = cosf(ang); C.sinT[i] = sinf(ang); }
    for (int m = gw; m < MTOK; m += NGW) {
        const f32x4* xr = (const f32x4*)(C.x + (size_t)m * DM) + lane; float s = 0.f;
        u32x2* o = (u32x2*)(C.XB + (size_t)m * DM) + lane;
#pragma unroll
        for (int j = 0; j < 8; ++j) { const f32x4 v = xr[64 * j]; s += (v[0] * v[0] + v[1] * v[1]) + (v[2] * v[2] + v[3] * v[3]); u32x2 w; w.x = pk_bf16(v[0], v[1]); w.y = pk_bf16(v[2], v[3]); o[64 * j] = w; }
#pragma unroll
        for (int of = 1; of < 64; of <<= 1) s += __shfl_xor(s, of);
        if (lane == 0) C.rowss[m] = (u64)(long long)__float2ll_rn(s * RSS_SCALE);
    }
    LAS float* scr = (LAS float*)(lds + wave * 16384);
    constexpr int NBIN = (NIN + 31) / 32, I_IN = 32 * NBIN, I_A = 24 * 64, I_B = 8 * 64, I_O = 32 * 64, I_L = I_IN + 2 * I_A + I_B + I_O;
    for (int i = gt; i < NLAYER * 232 * 256; i += NGT) { const int l = i / (232 * 256), r = i % (232 * 256); *(u32x4*)(C.WIN + ((size_t)l * NP + 13848 + (r >> 8)) * DM + (r & 255) * 8) = (u32x4){0u, 0u, 0u, 0u}; }
    for (int it = gw; it < NLAYER * I_L; it += NGW) {
        const int l = it / I_L; int r = it - l * I_L;
        if (r < I_IN) { transpose_item<true>(C.w_in + (size_t)l * DM * NIN, NIN, C.WIN + (size_t)l * NP * DM, DM, 0, C.norm_w + l * DM, scr, r / NBIN, r % NBIN, lane); continue; } r -= I_IN;
        bf16_t* wbr = C.WBR + (size_t)l * DM * KBR;
        if (r < I_A) { transpose_item<false>(C.wa + (size_t)l * 1536 * DM, DM, wbr, KBR, 0, nullptr, scr, r / 64, r % 64, lane); continue; } r -= I_A;
        if (r < I_B) { transpose_item<false>(C.wb + (size_t)l * 512 * DM, DM, wbr, KBR, 1536, nullptr, scr, r / 64, r % 64, lane); continue; } r -= I_B;
        if (r < I_A) { transpose_item<false>(C.wc + (size_t)l * 1536 * DM, DM, wbr, KBR, 2048, nullptr, scr, r / 64, r % 64, lane); continue; } r -= I_A;
        transpose_item<false>(C.wout + (size_t)l * DM * DM, DM, C.WOUT + (size_t)l * DM * DM, DM, 0, nullptr, scr, r / 64, r % 64, lane);
    }
}

__device__ __forceinline__ void gmlp_item(const Ctx& C, int layer, int item, LAS unsigned char* lds) {
    int tid = threadIdx.x; asm volatile("" : "+v"(tid));
    const int w = __builtin_amdgcn_readfirstlane(tid >> 6), lane = tid & 63, fr = lane & 15, fq = lane >> 4;
    const int b = item / 192, c = (item / 12) % 16, g = item % 12;
    const int row0 = b * SEQ + 128 * c;
    LAS unsigned char* WS = lds; LAS unsigned char* VT = lds + 34816;
    const float* Wg = C.gws + ((size_t)(layer * 12 + g)) * 128 * 128;
    const u64* lnst = C.lnst + (size_t)layer * MTOK * 2;
    const float* lw = C.ln_w + layer * 1536 + g * 128; const float* lb = C.ln_b + layer * 1536 + g * 128;
    const int t = 16 * w + fr, row = row0 + t;
    const float bs = C.gbs[(layer * 12 + g) * 128 + t];
    u32x2 uu8[8], zz8[8];
#pragma unroll
    for (int e = 0; e < 8; ++e) { const int col = g * 128 + 16 * e + 4 * fq; uu8[e] = *(const u32x2*)(C.P + (size_t)row * NP + C_U + col); zz8[e] = *(const u32x2*)(C.P + (size_t)row * NP + C_ZA + col); }
#pragma unroll
    for (int idx = tid; idx < 2048; idx += 512) {
        const int t = idx >> 4, ch = idx & 15;
        const f32x4 w0 = *(const f32x4*)(Wg + t * 128 + ch * 8), w1 = *(const f32x4*)(Wg + t * 128 + ch * 8 + 4);
        float v[8] = {w0[0], w0[1], w0[2], w0[3], w1[0], w1[1], w1[2], w1[3]};
#pragma unroll
        for (int j = 0; j < 8; ++j) if (ch * 8 + j > t) v[j] = 0.f;
        *(LAS u32x4*)(WS + t * 272 + ch * 16) = pack8(v);
        const int row = row0 + t;
        const float mu = fx_get(lnst + 2 * row, 1.f / LNS_SCALE) * (1.f / 1536.f), var = fx_get(lnst + 2 * row + 1, 1.f / LNS_SCALE) * (1.f / 1536.f) - mu * mu, rstd = rsqrtf(fmaxf(var, 0.f) + 1e-5f);
        float x[8]; unpack8(*(const u32x4*)(C.P + (size_t)row * NP + C_V + g * 128 + ch * 8), x);
        const f32x4 g0 = *(const f32x4*)(lw + ch * 8), g1 = *(const f32x4*)(lw + ch * 8 + 4), b0 = *(const f32x4*)(lb + ch * 8), b1 = *(const f32x4*)(lb + ch * 8 + 4);
        const float gw[8] = {g0[0], g0[1], g0[2], g0[3], g1[0], g1[1], g1[2], g1[3]}, gb[8] = {b0[0], b0[1], b0[2], b0[3], b1[0], b1[1], b1[2], b1[3]};
        LAS bf16_t* vt = (LAS bf16_t*)VT + (ch * 8) * 136 + swz(ch * 8, t);
#pragma unroll
        for (int j = 0; j < 8; ++j) { const float y = (x[j] - mu) * rstd * gw[j] + gb[j]; vt[j * 136] = (bf16_t)(pk_bf16(y, 0.f) & 0xffffu); }
    }
    __syncthreads();
    f32x4 acc[8];
#pragma unroll
    for (int e = 0; e < 8; ++e) acc[e] = (f32x4){0.f, 0.f, 0.f, 0.f};
    const int ksmax = w >> 1;
    for (int ks = 0; ks <= ksmax; ++ks) {
        const bf16x8 wf = ldsfrag(WS + (16 * w + fr) * 272 + (32 * ks + 8 * fq) * 2);
#pragma unroll
        for (int e = 0; e < 8; ++e) { const bf16x8 vf = ldsfrag(VT + (16 * e + fr) * 272 + swz(16 * e + fr, 32 * ks + 8 * fq) * 2); acc[e] = MFMA16(vf, wf, acc[e]); }
    }
#pragma unroll
    for (int e = 0; e < 8; ++e) {
        const int col = g * 128 + 16 * e + 4 * fq;
        const u32x2 uu = uu8[e], zz = zz8[e];
        u32x2 o; o.x = pk_bf16(bf_lo(uu.x) * (acc[e][0] + bs) * bf_lo(zz.x), bf_hi(uu.x) * (acc[e][1] + bs) * bf_hi(zz.x));
        o.y = pk_bf16(bf_lo(uu.y) * (acc[e][2] + bs) * bf_lo(zz.y), bf_hi(uu.y) * (acc[e][3] + bs) * bf_hi(zz.y));
        *(u32x2*)(C.Y + (size_t)row * KBR + col) = o;
    }
    __syncthreads();
}

__device__ __forceinline__ void attn_item(const Ctx& C, int item, LAS unsigned char* lds) {
    int tid = threadIdx.x; asm volatile("" : "+v"(tid));
    const int w = __builtin_amdgcn_readfirstlane(tid >> 6), lane = tid & 63, fr = lane & 15, fq = lane >> 4;
    const int grp = item >> 8, r = item & 255, b = r >> 6, j = (r >> 4) & 3;
    int d, cls, qb;
    if (grp == 0) { d = 1; cls = 0; qb = r & 15; } else if (grp == 1) { d = 4; cls = (r >> 2) & 3; qb = r & 3; } else { d = 16; cls = r & 15; qb = 0; }
    const int head = grp * 4 + j;
    LAS unsigned char* KS = lds; LAS unsigned char* VT = lds + 69632;
    const bf16_t* Pq = C.P + C_Q + head * 128; const bf16_t* Pk = C.P + C_K + head * 128; const bf16_t* Pv = C.P + C_VV + head * 128;
#pragma unroll
    for (int idx = tid; idx < 4096; idx += 512) {
        const int kk = idx >> 4, ch = idx & 15, n = 128 * (qb - 1) + kk;
        if (qb == 0 && idx < 2048) continue;
        u32x4 kv = {0u, 0u, 0u, 0u}, vv = {0u, 0u, 0u, 0u};
        if (n >= 0) { const size_t row = (size_t)b * SEQ + d * n + cls; kv = *(const u32x4*)(Pk + row * NP + ch * 8); vv = *(const u32x4*)(Pv + row * NP + ch * 8); }
        *(LAS u32x4*)(KS + kk * 272 + ch * 16) = kv;
        LAS bf16_t* vt = (LAS bf16_t*)VT + (ch * 8) * 264 + swz(ch * 8, kk);
        vt[0 * 264] = (bf16_t)(vv.x & 0xffffu); vt[1 * 264] = (bf16_t)(vv.x >> 16); vt[2 * 264] = (bf16_t)(vv.y & 0xffffu); vt[3 * 264] = (bf16_t)(vv.y >> 16);
        vt[4 * 264] = (bf16_t)(vv.z & 0xffffu); vt[5 * 264] = (bf16_t)(vv.z >> 16); vt[6 * 264] = (bf16_t)(vv.w & 0xffffu); vt[7 * 264] = (bf16_t)(vv.w >> 16);
    }
    const int qi = 16 * w + fr;
    const size_t rowq = (size_t)b * SEQ + d * (128 * qb + qi) + cls;
    bf16x8 qf[4];
#pragma unroll
    for (int ks = 0; ks < 4; ++ks) qf[ks] = *(const bf16x8*)(Pq + rowq * NP + ks * 32 + fq * 8);
    __syncthreads();
    const int lo = (qb > 0) ? w : (w > 8 ? w : 8), hi = w + 8;
    f32x4 S[16];
    float mx = -INFINITY;
#pragma unroll
    for (int kt = 0; kt < 16; ++kt) {
        S[kt] = (f32x4){-INFINITY, -INFINITY, -INFINITY, -INFINITY};
        if (kt >= lo && kt <= hi) {
            f32x4 a = {0.f, 0.f, 0.f, 0.f};
#pragma unroll
            for (int ks = 0; ks < 4; ++ks) a = MFMA16(ldsfrag(KS + (16 * kt + fr) * 272 + (32 * ks + 8 * fq) * 2), qf[ks], a);
#pragma unroll
            for (int rr = 0; rr < 4; ++rr) { const int kk = 16 * kt + 4 * fq + rr, dist = 128 + qi - kk; const bool ok = dist >= 0 && dist <= 128 && (qb > 0 || kk >= 128); const float s = ok ? a[rr] : -INFINITY; S[kt][rr] = s; mx = fmaxf(mx, s); }
        }
    }
    mx = fmaxf(mx, __shfl_xor(mx, 16)); mx = fmaxf(mx, __shfl_xor(mx, 32));
    float sum = 0.f;
#pragma unroll
    for (int kt = 0; kt < 16; ++kt)
#pragma unroll
        for (int rr = 0; rr < 4; ++rr) { const float p = fexp(S[kt][rr] - mx); S[kt][rr] = p; sum += p; }
    sum += __shfl_xor(sum, 16); sum += __shfl_xor(sum, 32);
    const float inv = 1.f / sum;
    bf16x8 pf[8];
#pragma unroll
    for (int u = 0; u < 8; ++u) { u32x4 t; t.x = pk_bf16(S[2 * u][0], S[2 * u][1]); t.y = pk_bf16(S[2 * u][2], S[2 * u][3]); t.z = pk_bf16(S[2 * u + 1][0], S[2 * u + 1][1]); t.w = pk_bf16(S[2 * u + 1][2], S[2 * u + 1][3]); pf[u] = __builtin_bit_cast(bf16x8, t); }
    bf16_t* og = C.OG + ((size_t)grp * MTOK + rowq) * 512 + j * 128;
#pragma unroll
    for (int et = 0; et < 8; ++et) {
        f32x4 a = {0.f, 0.f, 0.f, 0.f};
#pragma unroll
        for (int u = 0; u < 8; ++u) if (2 * u + 1 >= lo && 2 * u <= hi) {
            const LAS unsigned char* vr = VT + (16 * et + fr) * 528;
            a = MFMA16(frag2(*(const LAS u32x2*)(vr + swz(16 * et + fr, 32 * u + 4 * fq) * 2), *(const LAS u32x2*)(vr + swz(16 * et + fr, 32 * u + 16 + 4 * fq) * 2)), pf[u], a);
        }
        u32x2 o; o.x = pk_bf16(a[0] * inv, a[1] * inv); o.y = pk_bf16(a[2] * inv, a[3] * inv);
        *(u32x2*)(og + 16 * et + 4 * fq) = o;
    }
    if (fq == 0) C.lse[((size_t)grp * MTOK + rowq) * 4 + j] = mx + logf(sum);
    __syncthreads();
}

__device__ __forceinline__ void ssd1_item(const Ctx& C, int layer, int item, LAS unsigned char* lds) {
    int tid = threadIdx.x; asm volatile("" : "+v"(tid));
    const int w = __builtin_amdgcn_readfirstlane(tid >> 6), lane = tid & 63, fr = lane & 15, fq = lane >> 4;
    const int b = item >> 6, c = (item >> 2) & 15, g = item & 3;
    const int row0 = b * SEQ + 128 * c;
    LAS unsigned char* XT = lds; LAS unsigned char* BT = lds + 104448;
    LAS float* cumS = (LAS float*)(lds + 139264); LAS float* wS = (LAS float*)(lds + 142336);
    if (w < 6) {
        const int h = 6 * g + w, l0 = 2 * lane;
        const float dt0 = C.dtb[(size_t)(row0 + l0) * 24 + h], dt1 = C.dtb[(size_t)(row0 + l0 + 1) * 24 + h];
        const float a = -expf(C.a_log[layer * 24 + h]);
        const float da0 = dt0 * a, da1 = dt1 * a; float s = da0 + da1;
#pragma unroll
        for (int o = 1; o < 64; o <<= 1) { const float t = __shfl_up(s, o); if (lane >= o) s += t; }
        const float c1 = s, c0 = s - da1, last = __shfl(s, 63);
        cumS[w * 128 + l0] = c0; cumS[w * 128 + l0 + 1] = c1;
        C.cum[(size_t)(row0 + l0) * 24 + h] = c0; C.cum[(size_t)(row0 + l0 + 1) * 24 + h] = c1;
        wS[w * 128 + l0] = dt0 * expf(last - c0); wS[w * 128 + l0 + 1] = dt1 * expf(last - c1);
        if (lane == 0) C.cdec[(b * 16 + c) * 24 + h] = expf(last);
    }
    __syncthreads();
    const float* cw = C.conv_w + (size_t)layer * 4 * 2560; const float* cbv = C.conv_b + (size_t)layer * 2560;
#pragma unroll 4
    for (int idx = tid; idx < 128 * 80; idx += 512) {
        const int s = (idx >> 4) & 127, ch8 = (idx >> 11) * 16 + (idx & 15);
        const int cb = ch8 < 48 ? 384 * g + 8 * ch8 : (ch8 < 64 ? 1536 + 128 * g + 8 * (ch8 - 48) : 2048 + 128 * g + 8 * (ch8 - 64));
        const f32x4 bb0 = *(const f32x4*)(cbv + cb), bb1 = *(const f32x4*)(cbv + cb + 4);
        float o[8] = {bb0[0], bb0[1], bb0[2], bb0[3], bb1[0], bb1[1], bb1[2], bb1[3]};
#pragma unroll
        for (int t = 0; t < 4; ++t) {
            const int tok = 128 * c + s - 3 + t;
            if (tok >= 0) {
                float x[8]; unpack8(*(const u32x4*)(C.P + (size_t)(b * SEQ + tok) * NP + C_XBC + cb), x);
                const f32x4 k0 = *(const f32x4*)(cw + t * 2560 + cb), k1 = *(const f32x4*)(cw + t * 2560 + cb + 4);
                o[0] += k0[0] * x[0]; o[1] += k0[1] * x[1]; o[2] += k0[2] * x[2]; o[3] += k0[3] * x[3]; o[4] += k1[0] * x[4]; o[5] += k1[1] * x[5]; o[6] += k1[2] * x[6]; o[7] += k1[3] * x[7];
            }
        }
#pragma unroll
        for (int jj = 0; jj < 8; ++jj) o[jj] = silu_(o[jj]);
        *(u32x4*)(C.XCV + (size_t)(row0 + s) * 2560 + cb) = pack8(o);
        if (ch8 < 48) {
            const float sc = wS[(ch8 >> 3) * 128 + s];
            LAS bf16_t* xt = (LAS bf16_t*)XT + (ch8 * 8) * 136 + swz(ch8 * 8, s);
#pragma unroll
            for (int jj = 0; jj < 8; ++jj) xt[jj * 136] = (bf16_t)(pk_bf16(o[jj] * sc, 0.f) & 0xffffu);
        } else if (ch8 < 64) {
            LAS bf16_t* bt = (LAS bf16_t*)BT + ((ch8 - 48) * 8) * 136 + swz((ch8 - 48) * 8, s);
#pragma unroll
            for (int jj = 0; jj < 8; ++jj) bt[jj * 136] = (bf16_t)(pk_bf16(o[jj], 0.f) & 0xffffu);
        }
    }
    __syncthreads();
#ifndef DBG_NO_STATES
    for (int pi = 0; pi < 3; ++pi) {
        const int pt = 3 * w + pi, hh = pt >> 2, p = (pt & 3) * 16 + fr;
        bf16x8 xf[4];
#pragma unroll
        for (int ks = 0; ks < 4; ++ks) xf[ks] = ldsfrag(XT + (16 * pt + fr) * 272 + swz(16 * pt + fr, 32 * ks + 8 * fq) * 2);
        bf16_t* st = C.ST + ((size_t)((b * 16 + c) * 24 + 6 * g + hh) * 64 + p) * 128;
#pragma unroll
        for (int nt = 0; nt < 8; ++nt) {
            f32x4 a = {0.f, 0.f, 0.f, 0.f};
#pragma unroll
            for (int ks = 0; ks < 4; ++ks) a = MFMA16(ldsfrag(BT + (16 * nt + fr) * 272 + swz(16 * nt + fr, 32 * ks + 8 * fq) * 2), xf[ks], a);
            u32x2 o; o.x = pk_bf16(a[0], a[1]); o.y = pk_bf16(a[2], a[3]);
            *(u32x2*)(st + 16 * nt + 4 * fq) = o;
        }
    }
#endif
    __syncthreads();
}

__device__ __forceinline__ void ssd2_item(const Ctx& C, int layer, int item, LAS unsigned char* lds) {
    int tid = threadIdx.x; asm volatile("" : "+v"(tid));
    const int w = __builtin_amdgcn_readfirstlane(tid >> 6), lane = tid & 63, fr = lane & 15, fq = lane >> 4;
    const int b = item >> 6, c = (item >> 2) & 15, g = item & 3;
    const int row0 = b * SEQ + 128 * c;
    LAS unsigned char* XT = lds; LAS unsigned char* BM = lds + 104448;
    LAS float* cumS = (LAS float*)(lds + 139264); LAS float* dtS = (LAS float*)(lds + 142336);
    for (int idx = tid; idx < 768; idx += 512) { const int hh = idx >> 7, l = idx & 127; cumS[idx] = C.cum[(size_t)(row0 + l) * 24 + 6 * g + hh]; dtS[idx] = C.dtb[(size_t)(row0 + l) * 24 + 6 * g + hh]; }
#pragma unroll
    for (int idx = tid; idx < 2048; idx += 512) { const int s = idx >> 4, ch = idx & 15; *(LAS u32x4*)(BM + s * 272 + ch * 16) = *(const u32x4*)(C.XCV + (size_t)(row0 + s) * 2560 + 1536 + 128 * g + 8 * ch); }
    __syncthreads();
#pragma unroll 4
    for (int idx = tid; idx < 128 * 48; idx += 512) {
        const int s = (idx >> 4) & 127, ch8 = (idx >> 11) * 16 + (idx & 15);
        float x[8]; unpack8(*(const u32x4*)(C.XCV + (size_t)(row0 + s) * 2560 + 384 * g + 8 * ch8), x);
        const float sc = dtS[(ch8 >> 3) * 128 + s];
        LAS bf16_t* xt = (LAS bf16_t*)XT + (ch8 * 8) * 136 + swz(ch8 * 8, s);
#pragma unroll
        for (int jj = 0; jj < 8; ++jj) xt[jj * 136] = (bf16_t)(pk_bf16(x[jj] * sc, 0.f) & 0xffffu);
    }
    const int t = 16 * w + fr, row = row0 + t;
    bf16x8 cf[4];
#pragma unroll
    for (int ks = 0; ks < 4; ++ks) cf[ks] = *(const bf16x8*)(C.XCV + (size_t)row * 2560 + 2048 + 128 * g + 32 * ks + 8 * fq);
    f32x4 cbt[8];
#pragma unroll
    for (int st = 0; st < 8; ++st) {
        cbt[st] = (f32x4){0.f, 0.f, 0.f, 0.f};
        if (st <= w) {
#pragma unroll
            for (int ks = 0; ks < 4; ++ks) cbt[st] = MFMA16(ldsfrag(BM + (16 * st + fr) * 272 + (32 * ks + 8 * fq) * 2), cf[ks], cbt[st]);
        }
    }
    __syncthreads();
    float ss = 0.f;
    const int pp = tid >> 3, n0 = (tid & 7) * 16;
    u32x4 nq0, nq1;
    { const bf16_t* sp = C.PREV + ((size_t)((b * 16 + c) * 24 + 6 * g) * 64 + pp) * 128 + n0; nq0 = *(const u32x4*)sp; nq1 = *(const u32x4*)(sp + 8); }
#pragma unroll 1
    for (int hh = 0; hh < 6; ++hh) {
        const int h = 6 * g + hh;
        LAS unsigned char* PV = BM + (hh & 1) * 17408;
        {
            *(LAS u32x4*)(PV + pp * 272 + n0 * 2) = nq0; *(LAS u32x4*)(PV + pp * 272 + n0 * 2 + 16) = nq1;
            if (hh < 5) { const bf16_t* sp = C.PREV + ((size_t)((b * 16 + c) * 24 + h + 1) * 64 + pp) * 128 + n0; nq0 = *(const u32x4*)sp; nq1 = *(const u32x4*)(sp + 8); }
        }
        u32x2 xx4[4], zz4[4];
#pragma unroll
        for (int pt = 0; pt < 4; ++pt) { const int ch = 384 * g + 64 * hh + 16 * pt + 4 * fq; xx4[pt] = *(const u32x2*)(C.XCV + (size_t)row * 2560 + ch); zz4[pt] = *(const u32x2*)(C.P + (size_t)row * NP + C_ZC + ch); }
        __syncthreads();
        const float cum_t = cumS[hh * 128 + t], e_t = expf(cum_t), dsk = C.d_skip[layer * 24 + h];
        bf16x8 gf[4];
#pragma unroll
        for (int u = 0; u < 4; ++u) {
            const f32x4 ca = *(const LAS f32x4*)(cumS + hh * 128 + 32 * u + 4 * fq), cb2 = *(const LAS f32x4*)(cumS + hh * 128 + 32 * u + 16 + 4 * fq);
            float gv[8];
#pragma unroll
            for (int rr = 0; rr < 4; ++rr) {
                const int s0 = 32 * u + 4 * fq + rr, s1 = s0 + 16;
                gv[rr] = (s0 <= t) ? cbt[2 * u][rr] * expf(cum_t - ca[rr]) : 0.f;
                gv[4 + rr] = (s1 <= t) ? cbt[2 * u + 1][rr] * expf(cum_t - cb2[rr]) : 0.f;
            }
            gf[u] = __builtin_bit_cast(bf16x8, pack8(gv));
        }
#pragma unroll
        for (int pt = 0; pt < 4; ++pt) {
            f32x4 ao = {0.f, 0.f, 0.f, 0.f}, ad = {0.f, 0.f, 0.f, 0.f};
#pragma unroll
            for (int ks = 0; ks < 4; ++ks) ao = MFMA16(ldsfrag(PV + (16 * pt + fr) * 272 + (32 * ks + 8 * fq) * 2), cf[ks], ao);
#pragma unroll
            for (int u = 0; u < 4; ++u) if (u <= (w >> 1)) {
                const int xrow = 64 * hh + 16 * pt + fr; const LAS unsigned char* xr = XT + xrow * 272;
                ad = MFMA16(frag2(*(const LAS u32x2*)(xr + swz(xrow, 32 * u + 4 * fq) * 2), *(const LAS u32x2*)(xr + swz(xrow, 32 * u + 16 + 4 * fq) * 2)), gf[u], ad);
            }
            const int ch = 384 * g + 64 * hh + 16 * pt + 4 * fq;
            const u32x2 xx = xx4[pt], zz = zz4[pt];
            const float y0 = (ad[0] + e_t * ao[0] + dsk * bf_lo(xx.x)) * bf_lo(zz.x), y1 = (ad[1] + e_t * ao[1] + dsk * bf_hi(xx.x)) * bf_hi(zz.x);
            const float y2 = (ad[2] + e_t * ao[2] + dsk * bf_lo(xx.y)) * bf_lo(zz.y), y3 = (ad[3] + e_t * ao[3] + dsk * bf_hi(xx.y)) * bf_hi(zz.y);
            ss += (y0 * y0 + y1 * y1) + (y2 * y2 + y3 * y3);
            u32x2 yo; yo.x = pk_bf16(y0, y1); yo.y = pk_bf16(y2, y3); *(u32x2*)(C.Y + (size_t)row * KBR + 2048 + ch) = yo;
        }
    }
    ss += __shfl_xor(ss, 16); ss += __shfl_xor(ss, 32);
    const float rstd = rsqrtf(ss * (1.f / 384.f) + 1e-5f);
    const float* nw = C.ssm_nw + layer * 1536;
#pragma unroll 2
    for (int q = 0; q < 24; ++q) {
            const int ch = 384 * g + 16 * q + 4 * fq;
            const f32x4 nv = *(const f32x4*)(nw + ch);
            u32x2* yp = (u32x2*)(C.Y + (size_t)row * KBR + 2048 + ch); const u32x2 yy = *yp;
            u32x2 o; o.x = pk_bf16(bf_lo(yy.x) * rstd * nv[0], bf_hi(yy.x) * rstd * nv[1]); o.y = pk_bf16(bf_lo(yy.y) * rstd * nv[2], bf_hi(yy.y) * rstd * nv[3]);
            *yp = o;
        }
    __syncthreads();
}
__device__ __forceinline__ void scan_states(const Ctx& C) {
    int tid = threadIdx.x; asm volatile("" : "+v"(tid));
    const int gt = blockIdx.x * 512 + tid, NGT = gridDim.x * 512;
    for (int task = gt; task < 96 * 1024; task += NGT) {
        const int bh = task >> 10, e8 = task & 1023, b = bh / 24, h = bh - 24 * b;
        u32x4 v[15]; float d[15];
#pragma unroll
        for (int c = 0; c < 15; ++c) { v[c] = *(const u32x4*)(C.ST + (size_t)((b * 16 + c) * 24 + h) * 8192 + e8 * 8); d[c] = C.cdec[(b * 16 + c) * 24 + h]; }
        float car[8] = {0.f, 0.f, 0.f, 0.f, 0.f, 0.f, 0.f, 0.f};
#pragma unroll
        for (int c = 0; c < 16; ++c) {
            *(u32x4*)(C.PREV + (size_t)((b * 16 + c) * 24 + h) * 8192 + e8 * 8) = pack8(car);
            if (c < 15) { float sv[8]; unpack8(v[c], sv);
#pragma unroll
                for (int i = 0; i < 8; ++i) car[i] = car[i] * d[c] + sv[i]; }
        }
    }
}
__device__ __forceinline__ void combine_item(const Ctx& C, int item) {
    int tid = threadIdx.x; asm volatile("" : "+v"(tid));
#pragma unroll
    for (int idx = tid; idx < 32 * 64; idx += 512) {
        const int row = item * 32 + (idx >> 6), chunk = idx & 63, j = chunk >> 4;
        const float l0 = C.lse[((size_t)0 * MTOK + row) * 4 + j], l1 = C.lse[((size_t)1 * MTOK + row) * 4 + j], l2 = C.lse[((size_t)2 * MTOK + row) * 4 + j];
        const float m = fmaxf(l0, fmaxf(l1, l2)); float w0 = expf(l0 - m), w1 = expf(l1 - m), w2 = expf(l2 - m); const float iv = 1.f / (w0 + w1 + w2); w0 *= iv; w1 *= iv; w2 *= iv;
        float a0[8], a1[8], a2[8], z[8];
        unpack8(*(const u32x4*)(C.OG + ((size_t)0 * MTOK + row) * 512 + chunk * 8), a0); unpack8(*(const u32x4*)(C.OG + ((size_t)1 * MTOK + row) * 512 + chunk * 8), a1);
        unpack8(*(const u32x4*)(C.OG + ((size_t)2 * MTOK + row) * 512 + chunk * 8), a2); unpack8(*(const u32x4*)(C.P + (size_t)row * NP + C_ZB + chunk * 8), z);
        float o[8];
#pragma unroll
        for (int i = 0; i < 8; ++i) o[i] = (w0 * a0[i] + w1 * a1[i] + w2 * a2[i]) * z[i];
        *(u32x4*)(C.Y + (size_t)row * KBR + 1536 + chunk * 8) = pack8(o);
    }
}


#ifdef DBG_LAST
__device__ __forceinline__ float dbg_bf(const bf16_t* p, size_t i) { return __uint_as_float(((unsigned)p[i]) << 16); }
__global__ void __launch_bounds__(512) dbg_dump(Ctx C) {
    const size_t NO = (size_t)MTOK * DM;
    for (size_t i = (size_t)blockIdx.x * 512 + threadIdx.x; i < NO; i += (size_t)gridDim.x * 512) {
        float v = 0.f;
#if DBG_MASK & 1
        { const size_t row = i / DM, c = i % DM; for (int j = 0; j < 10; ++j) { const size_t cc = c + (size_t)j * DM; if (cc < NP && !(cc >= 13848 && cc < C_GR)) v += dbg_bf(C.P, row * NP + cc); }
          if (c < 24) v += C.dtb[row * 24 + c]; v += dbg_bf(C.XB, i); }
#endif
#if DBG_MASK & 2
        { const size_t row = i / DM, c = i % DM; if (c < 1536) v += dbg_bf(C.Y, row * KBR + c); v += dbg_bf(C.XCV, row * 2560 + c); if (c < 512) v += dbg_bf(C.XCV, row * 2560 + 2048 + c);
          if (i < (size_t)3 * MTOK * 512) v += dbg_bf(C.OG, i); if (i < (size_t)3 * MTOK * 4) v += C.lse[i]; if (i < (size_t)4 * 16 * 24 * 64 * 128) v += dbg_bf(C.ST, i);
          if (c < 24) v += C.cum[row * 24 + c]; if (i < 4 * 16 * 24) v += C.cdec[i]; }
#endif
#if DBG_MASK & 4
        { const size_t row = i / DM, c = i % DM; v += dbg_bf(C.Y, row * KBR + c); if (c < 1536) v += dbg_bf(C.Y, row * KBR + 2048 + c); }
#endif
#if DBG_MASK & 8
        v += dbg_bf(C.MGB, i);
#endif
#if DBG_MASK & 16
        v += C.X32[i];
#endif
        C.out[i] = v;
    }
}
#endif
__device__ __forceinline__ const float* ldp(const float** t, int i) {
    const unsigned long long v = (unsigned long long)t[i];
    const unsigned lo = __builtin_amdgcn_readfirstlane((unsigned)v), hi = __builtin_amdgcn_readfirstlane((unsigned)(v >> 32));
    return (const float*)(((unsigned long long)hi << 32) | lo);
}
#define XB_TMO      128
#define XB_XCNT(j)  (256  + 64 * (j))
#define XB_XSUB(j)  (1280 + 64 * (j))
#define XB_XGEN(j)  (2304 + 64 * (j))
#define XB_TOP      3328
#define XB_TOPGEN   3392
#define XCD_BAR_WORDS 3456
#define XB_SPIN_CAP (1u << 18)

__device__ __forceinline__ unsigned xb_ld(unsigned* p)              { return __hip_atomic_load(p, __ATOMIC_RELAXED, __HIP_MEMORY_SCOPE_AGENT); }
__device__ __forceinline__ unsigned xb_add(unsigned* p, unsigned v) { return __hip_atomic_fetch_add(p, v, __ATOMIC_RELAXED, __HIP_MEMORY_SCOPE_AGENT); }
__device__ __forceinline__ unsigned xb_xcc_id() { return (unsigned)__builtin_amdgcn_s_getreg((3 << 11) | 20) & 0xFu; }
#define XB_SPIN(cond, bar) do { unsigned _sp = 0; while (cond) { __builtin_amdgcn_s_sleep(1); \
    if ((++_sp & 255u) == 0u) { if (xb_ld(&(bar)[XB_TMO])) break; if (_sp > XB_SPIN_CAP) { atomicAdd(&(bar)[XB_TMO], 1u); break; } } } } while (0)

struct XcdBarrier {
    unsigned* bar; unsigned x;
    volatile LAS unsigned* st;
};

__device__ __forceinline__ XcdBarrier xcd_barrier_post(unsigned* bar, volatile LAS unsigned* st) {
    XcdBarrier b; b.bar = bar; b.x = xb_xcc_id(); b.st = st;
    if (threadIdx.x == 0) (void)xb_add(&bar[XB_XCNT(b.x)], 1u);
    return b;
}
__device__ __forceinline__ void xcd_barrier_complete(unsigned* bar, unsigned x, unsigned& nloc, unsigned& nx) {
    const unsigned G = gridDim.x * gridDim.y * gridDim.z;
    unsigned sum, cnt, mine, sp = 0u;
    for (;;) {
        sum = 0u; cnt = 0u; mine = 0u;
#pragma unroll
        for (unsigned j = 0; j < 16; ++j) { const unsigned c = xb_ld(&bar[XB_XCNT(j)]); sum += c; cnt += (c > 0u) ? 1u : 0u; mine = (j == x) ? c : mine; }
        if (sum == G) break;
        __builtin_amdgcn_s_sleep(1);
        if ((++sp & 255u) == 0u) { if (xb_ld(&bar[XB_TMO])) break; if (sp > XB_SPIN_CAP) { atomicAdd(&bar[XB_TMO], 1u); break; } }
    }
    nloc = mine > 0u ? mine : 1u; nx = cnt > 0u ? cnt : 1u;
}

__device__ __forceinline__ void xcd_barrier(const XcdBarrier& b) {
    asm volatile("s_waitcnt vmcnt(0)" ::: "memory");
    __syncthreads();
    if (threadIdx.x == 0) {
        unsigned* bar = b.bar;
        __builtin_amdgcn_s_waitcnt(0);
        unsigned nloc = b.st[0], nx = b.st[1];
        if (nloc == 0u) { xcd_barrier_complete(bar, b.x, nloc, nx); b.st[0] = nloc; b.st[1] = nx; }
        const unsigned old = xb_add(&bar[XB_XSUB(b.x)], 1u);
        const unsigned gen = old / nloc;
        if (old + 1u == (gen + 1u) * nloc) {
            __builtin_amdgcn_fence(__ATOMIC_RELEASE, "agent");
            asm volatile("s_waitcnt vmcnt(0)" ::: "memory");
            const unsigned og = xb_add(&bar[XB_TOP], 1u);
            const unsigned tg = og / nx;
            if (og + 1u == (tg + 1u) * nx) xb_add(&bar[XB_TOPGEN], 1u);
            else XB_SPIN(xb_ld(&bar[XB_TOPGEN]) == tg, bar);
            __builtin_amdgcn_fence(__ATOMIC_ACQUIRE, "agent");
            xb_add(&bar[XB_XGEN(b.x)], 1u);
            asm volatile("s_waitcnt vmcnt(0)" ::: "memory");
        } else {
            XB_SPIN(xb_ld(&bar[XB_XGEN(b.x)]) == gen, bar);
            __builtin_amdgcn_fence(__ATOMIC_ACQUIRE, "agent");
            asm volatile("s_waitcnt vmcnt(0)" ::: "memory");
        }
    }
    __syncthreads();
}

__global__ void __launch_bounds__(512) mega(Params prm) {
    extern __shared__ __attribute__((aligned(16))) unsigned char lds_raw[];
    LAS unsigned char* lds = (LAS unsigned char*)lds_raw;
    Ctx C;
    C.x = prm.in[0]; C.norm_w = prm.in[1]; C.w_in = prm.in[2]; C.ln_w = prm.in[3]; C.ln_b = prm.in[4]; C.gws = prm.in[5]; C.gbs = prm.in[6]; C.conv_w = prm.in[7]; C.conv_b = prm.in[8];
    C.dt_bias = prm.in[9]; C.a_log = prm.in[10]; C.d_skip = prm.in[11]; C.ssm_nw = prm.in[12]; C.wa = prm.in[13]; C.wb = prm.in[14]; C.wc = prm.in[15]; C.wout = prm.in[16]; C.fnw = prm.in[17];
    C.out = prm.out; C.ws = prm.ws;
    unsigned char* ws = prm.ws;
    C.rowss = (u64*)(ws + WS_ROWSS); C.lnst = (u64*)(ws + WS_LNST); C.cosT = (float*)(ws + WS_COS); C.sinT = (float*)(ws + WS_SIN); C.dtb = (float*)(ws + WS_DTB); C.cum = (float*)(ws + WS_CUM);
    C.cdec = (float*)(ws + WS_CDEC); C.lse = (float*)(ws + WS_LSE); C.X32 = (float*)(ws + WS_X32); C.MG32 = (float*)(ws + WS_MG32);
    C.WIN = (bf16_t*)(ws + WS_WIN); C.WBR = (bf16_t*)(ws + WS_WBR); C.WOUT = (bf16_t*)(ws + WS_WOUT); C.XB = (bf16_t*)(ws + WS_XB); C.P = (bf16_t*)(ws + WS_P); C.XCV = (bf16_t*)(ws + WS_XCV);
    C.ST = (bf16_t*)(ws + WS_ST); C.OG = (bf16_t*)(ws + WS_OG); C.Y = (bf16_t*)(ws + WS_Y); C.MGB = (bf16_t*)(ws + WS_MGB); C.PREV = (bf16_t*)(ws + WS_PREV);
    const int G = gridDim.x, bid = blockIdx.x;
    volatile LAS unsigned* bst = (volatile LAS unsigned*)(lds + LDS_BYTES - 64);
    if (threadIdx.x == 0) { bst[0] = 0u; bst[1] = 0u; }
    __syncthreads();

    for (int ph = prm.ph_lo; ph < prm.ph_hi; ++ph) {
        if (ph == 0) {
#ifndef NO_P0
            phase_prologue(C, lds);
#ifdef PROBE_REP_P0
            __syncthreads(); phase_prologue(C, lds);
#endif
#endif
        } else if (ph == NPHASE - 1) {
            int tid = threadIdx.x; asm volatile("" : "+v"(tid));
            const int lane = tid & 63, gw = bid * 8 + (tid >> 6), NGW = G * 8;
            const u64* rss = C.rowss + 4 * MTOK;
            for (int m = gw; m < MTOK; m += NGW) {
                const float rs = rsqrtf(fx_get(rss + m, 1.f / RSS_SCALE) * (1.f / 2048.f) + 1e-6f);
                const f32x4* xr = (const f32x4*)(C.X32 + (size_t)m * DM) + lane; const f32x4* fw = (const f32x4*)C.fnw + lane; f32x4* o = (f32x4*)(C.out + (size_t)m * DM) + lane;
#pragma unroll
                for (int j = 0; j < 8; ++j) o[64 * j] = xr[64 * j] * rs * fw[64 * j];
            }
        } else {
            const int l = (ph - 1) / 5, sub = (ph - 1) % 5;
#ifdef PROBE_REP_SUB
            const int nrep = ((PROBE_REP_SUB >> sub) & 1) ? 2 : 1;
            for (int rep = 0; rep < nrep; ++rep) {
            if (rep) __syncthreads();
#endif
            if (sub == 0) {
                pg8::Gemm g{C.XB, C.WIN + (size_t)l * NP * DM, DM, DM}; pg8::Sched S; S.init(32, NP / 256, G, bid, 0, DM / 64);
                EpiProj E{C.P, C.rowss + l * MTOK, C.lnst + (size_t)l * MTOK * 2, C.dtb, C.dt_bias + l * 24, C.cosT, C.sinT, (bf16_t*)(C.ws + WS_GT)};
#ifndef NO_G1
                pg8::gemm_phase<EpiProj>(lds, g, S, E);
#endif
            } else if (sub == 1) {
                for (int it = bid; it < 1792; it += G) {
                    if (it < 256) {
#ifndef NO_SSD1
                        ssd1_item(C, l, it, lds);
#endif
                    } else if (it < 1024) {
#ifndef NO_ATTN
                        attn_item(C, it - 256, lds);
#endif
                    } else {
#ifndef NO_GMLP
                        gmlp_item(C, l, it - 1024, lds);
#endif
                    }
                }
            } else if (sub == 2) {
                scan_states(C);
                for (int it = bid; it < 256; it += G) combine_item(C, it);
                { XcdBarrier xb; xb.bar = (unsigned*)(prm.ws + WS_BAR); xb.x = xb_xcc_id(); xb.st = bst; xcd_barrier(xb); }
                for (int it = bid; it < 256; it += G) {
#ifndef NO_SSD2
                    ssd2_item(C, l, it, lds);
#endif
                }
            } else if (sub == 3) {
                pg8::Gemm g{C.Y, C.WBR + (size_t)l * DM * KBR, KBR, KBR}; pg8::Sched S; S.init(32, 8, G, bid, 1, 0);
                EpiBranch E{(const bf16_t*)(C.ws + WS_GT), C.MGB};
#ifndef NO_G2
                pg8::gemm_phase<EpiBranch>(lds, g, S, E);
#endif
            } else {
                pg8::Gemm g{C.MGB, C.WOUT + (size_t)l * DM * DM, DM, DM}; pg8::Sched S; S.init(32, 8, G, bid, 0, DM / 64);
                EpiOut E{C.x, C.X32, C.XB, C.rowss + (l + 1) * MTOK, l == 0 ? 0 : (l == NLAYER - 1 ? 2 : 1)};
#ifndef NO_G3
                pg8::gemm_phase<EpiOut>(lds, g, S, E);
#endif
            }
#ifdef PROBE_REP_SUB
            }
#endif
        }
        if (ph + 1 < prm.ph_hi) {
            if (ph == prm.ph_lo) {
                cg::this_grid().sync();
                (void)xcd_barrier_post((unsigned*)(prm.ws + WS_BAR), bst);
            } else {
                XcdBarrier xb; xb.bar = (unsigned*)(prm.ws + WS_BAR); xb.x = xb_xcc_id(); xb.st = bst;
                xcd_barrier(xb);
            }
        }
    }
}

extern "C" void kernel_launch(void* const* d_in, const int* in_sizes, int n_in, void* d_out, int out_size, void* d_ws, size_t ws_size, hipStream_t stream) {
    static int grid = 0;
    if (grid == 0) {
        if (n_in != 18 || ws_size < WS_END) { fprintf(stderr, "kernel_launch: unexpected inputs (n_in %d, ws %zu < %zu)\n", n_in, ws_size, (size_t)WS_END); grid = -1; return; }
        int dev = 0, cus = 0, per_cu = 0;
        hipGetDevice(&dev); hipDeviceGetAttribute(&cus, hipDeviceAttributeMultiprocessorCount, dev);
        hipFuncSetAttribute((const void*)mega, hipFuncAttributeMaxDynamicSharedMemorySize, LDS_BYTES);
        if (hipOccupancyMaxActiveBlocksPerMultiprocessor(&per_cu, (const void*)mega, 512, LDS_BYTES) != hipSuccess || per_cu < 1) per_cu = 1;
        (void)hipGetLastError();
        grid = cus * per_cu;
        if (grid <= 0) grid = 256;
    }
    if (grid < 0) return;
    Params p{};
    for (int i = 0; i < 18; ++i) p.in[i] = (const float*)d_in[i];
    p.out = (float*)d_out; p.ws = (unsigned char*)d_ws;
#if N_LAUNCH_MODE == 1
    p.ph_lo = 0; p.ph_hi = NPHASE;
    void* args[] = {&p};
    hipError_t e = hipLaunchCooperativeKernel((const void*)mega, dim3(grid), dim3(512), args, LDS_BYTES, stream);
    if (e != hipSuccess) fprintf(stderr, "cooperative launch failed: %s (grid %d)\n", hipGetErrorString(e), grid);
#else
#ifdef DBG_LAST
    for (int ph = 0; ph <= DBG_LAST; ++ph) { p.ph_lo = ph; p.ph_hi = ph + 1; hipLaunchKernelGGL(mega, dim3(grid), dim3(512), LDS_BYTES, stream, p); }
    { Ctx C{}; unsigned char* ws = (unsigned char*)d_ws; C.out = (float*)d_out; C.dtb = (float*)(ws + WS_DTB); C.cum = (float*)(ws + WS_CUM); C.cdec = (float*)(ws + WS_CDEC); C.lse = (float*)(ws + WS_LSE); C.X32 = (float*)(ws + WS_X32);
      C.XB = (bf16_t*)(ws + WS_XB); C.P = (bf16_t*)(ws + WS_P); C.XCV = (bf16_t*)(ws + WS_XCV); C.ST = (bf16_t*)(ws + WS_ST); C.OG = (bf16_t*)(ws + WS_OG); C.Y = (bf16_t*)(ws + WS_Y); C.MGB = (bf16_t*)(ws + WS_MGB);
      hipLaunchKernelGGL(dbg_dump, dim3(1024), dim3(512), 0, stream, C); }
#else
    for (int ph = 0; ph < NPHASE; ++ph) { p.ph_lo = ph; p.ph_hi = ph + 1; hipLaunchKernelGGL(mega, dim3(grid), dim3(512), LDS_BYTES, stream, p); }
#endif
#endif
}
```
